# Optimizing an MI355X kernel written in HIP

```python
import jax, jax.numpy as jnp
from jax import lax
import numpy as np

D_MODEL = 2048
BATCH = 1
SEQ = 16384
DEPTH = 1
DEC_BATCH = 2
DEC_SEQ = 8192
PAST_LEN = 128

HEAD_DIM = 128
A_HEADS = 8
A_KV_HEADS = 2
B_HEADS = 4
B_KV_HEADS = 2
M_HEADS = 4
N_MEM = 256
WINDOW = 128
BLOCK = 128
GRID_W = 64
ROPE_THETA = 10000.0
NORM_EPS = 1e-6
D_FF = ((8 * D_MODEL // 3 + 255) // 256) * 256

A_Q = A_HEADS * HEAD_DIM
A_KV = A_KV_HEADS * HEAD_DIM
B_Q = B_HEADS * HEAD_DIM
B_KV = B_KV_HEADS * HEAD_DIM
M_Q = M_HEADS * HEAD_DIM
MIX_WIDTH = A_Q + B_Q + M_Q
IN_WIDTH = A_Q + 2 * A_KV + B_Q + 2 * B_KV + M_Q
MEM_KV_WIDTH = 2 * M_Q
NEG_INF = -1e30

kernel_name = "hymba_window_axial_memory_encoder"


def rmsnorm(x, g):
    x32 = x.astype(jnp.float32)
    y = x32 * lax.rsqrt(jnp.mean(x32 * x32, axis=-1, keepdims=True) + NORM_EPS)
    return (y * g.astype(jnp.float32)).astype(x.dtype)


def rope_tables(pos, dim):
    inv = ROPE_THETA ** (-(jnp.arange(0, dim, 2, dtype=jnp.float32) / dim))
    ang = pos[:, None] * inv[None, :]
    return jnp.cos(ang), jnp.sin(ang)


def apply_rope(x, cos, sin):
    x32 = x.astype(jnp.float32)
    half = x.shape[-1] // 2
    x1, x2 = x32[..., :half], x32[..., half:]
    c, s = cos[None, :, None, :], sin[None, :, None, :]
    return jnp.concatenate([x1 * c - x2 * s, x2 * c + x1 * s], axis=-1).astype(x.dtype)


def window_attention(q, k, v, sink):
    B, S, H, D = q.shape
    KV = k.shape[2]
    G = H // KV
    nb = S // BLOCK
    qb = q.reshape(B, nb, BLOCK, KV, G, D)

    def band(t):
        tp = jnp.pad(t, ((0, 0), (BLOCK, BLOCK), (0, 0), (0, 0)))
        parts = [tp[:, i * BLOCK:i * BLOCK + S].reshape(B, nb, BLOCK, KV, D) for i in range(3)]
        return jnp.concatenate(parts, axis=2)

    kb, vb = band(k), band(v)
    logits = jnp.einsum('bnqkgd,bnskd->bnkgqs', qb, kb).astype(jnp.float32) * (D ** -0.5)
    n_idx = jnp.arange(nb)[:, None, None]
    q_pos = n_idx * BLOCK + jnp.arange(BLOCK)[None, :, None]
    k_pos = n_idx * BLOCK + jnp.arange(3 * BLOCK)[None, None, :] - BLOCK
    mask = (jnp.abs(k_pos - q_pos) <= WINDOW) & (k_pos >= 0) & (k_pos < S)
    logits = jnp.where(mask[None, :, None, None], logits, NEG_INF)
    sink_col = jnp.broadcast_to(sink.astype(jnp.float32).reshape(KV, G)[None, None, :, :, None, None],
                                logits.shape[:-1] + (1,))
    p = jax.nn.softmax(jnp.concatenate([logits, sink_col], axis=-1), axis=-1)[..., :-1]
    o = jnp.einsum('bnkgqs,bnskd->bnqkgd', p.astype(v.dtype), vb)
    return o.reshape(B, S, H * D)


def global_attention(q, k, v):
    B, S, H, D = q.shape
    KV = k.shape[2]
    G = H // KV
    nb = S // BLOCK
    qb = q.reshape(B, nb, BLOCK, KV, G, D).transpose(1, 0, 2, 3, 4, 5)

    def one_block(qi):
        s = jnp.einsum('bqkgd,bskd->bkgqs', qi, k).astype(jnp.float32) * (D ** -0.5)
        p = jax.nn.softmax(s, axis=-1).astype(v.dtype)
        return jnp.einsum('bkgqs,bskd->bqkgd', p, v)

    o = lax.map(one_block, qb)
    return o.transpose(1, 0, 2, 3, 4, 5).reshape(B, S, H * D)


def memory_attention(q, km, vm):
    D = q.shape[-1]
    s = jnp.einsum('bqhd,bmhd->bhqm', q, km).astype(jnp.float32) * (D ** -0.5)
    p = jax.nn.softmax(s, axis=-1).astype(vm.dtype)
    o = jnp.einsum('bhqm,bmhd->bqhd', p, vm)
    return o.reshape(q.shape[0], q.shape[1], -1)


def encoder_layer(x, mem, norm_mix_g, norm_mem_g, w_in, w_mem_kv, sink_a, q_norm_b_g, k_norm_b_g,
                  out_norm_g, w_out, norm_ffn_g, w_gate_up, w_down):
    B, S, _ = x.shape
    ROWS = S // GRID_W
    h = rmsnorm(x, norm_mix_g)
    proj = h @ w_in
    offs = np.cumsum([A_Q, A_KV, A_KV, B_Q, B_KV, B_KV])
    qa, ka, va, qb, kb, vb, qm = jnp.split(proj, offs, axis=-1)
    qa = qa.reshape(B, S, A_HEADS, HEAD_DIM)
    ka = ka.reshape(B, S, A_KV_HEADS, HEAD_DIM)
    va = va.reshape(B, S, A_KV_HEADS, HEAD_DIM)
    qb = qb.reshape(B, S, B_HEADS, HEAD_DIM)
    kb = kb.reshape(B, S, B_KV_HEADS, HEAD_DIM)
    vb = vb.reshape(B, S, B_KV_HEADS, HEAD_DIM)
    qm = qm.reshape(B, S, M_HEADS, HEAD_DIM)

    cos_t, sin_t = rope_tables(jnp.arange(S, dtype=jnp.float32), HEAD_DIM)
    oa = window_attention(apply_rope(qa, cos_t, sin_t), apply_rope(ka, cos_t, sin_t), va, sink_a)

    rows = jnp.repeat(jnp.arange(ROWS, dtype=jnp.float32), GRID_W, total_repeat_length=S)
    cols = jnp.tile(jnp.arange(GRID_W, dtype=jnp.float32), ROWS)
    half = HEAD_DIM // 2
    cos_r, sin_r = rope_tables(rows, half)
    cos_c, sin_c = rope_tables(cols, half)

    def axial(t):
        return jnp.concatenate([apply_rope(t[..., :half], cos_r, sin_r),
                                apply_rope(t[..., half:], cos_c, sin_c)], axis=-1)

    qb = axial(rmsnorm(qb, q_norm_b_g))
    kb = axial(rmsnorm(kb, k_norm_b_g))
    ob = global_attention(qb, kb, vb)

    kvm = rmsnorm(mem, norm_mem_g) @ w_mem_kv
    km, vm = jnp.split(kvm, 2, axis=-1)
    km = km.reshape(B, N_MEM, M_HEADS, HEAD_DIM)
    vm = vm.reshape(B, N_MEM, M_HEADS, HEAD_DIM)
    om = memory_attention(qm, km, vm)

    merged = jnp.concatenate([rmsnorm(oa, out_norm_g[:A_Q]),
                              rmsnorm(ob, out_norm_g[A_Q:A_Q + B_Q]),
                              rmsnorm(om, out_norm_g[A_Q + B_Q:])], axis=-1)
    x = x + merged @ w_out

    g, u = jnp.split(rmsnorm(x, norm_ffn_g) @ w_gate_up, 2, axis=-1)
    return x + (jax.nn.silu(g) * u) @ w_down


def trunk(x, mem, norm_mix_g, norm_mem_g, w_in, w_mem_kv, sink_a, q_norm_b_g, k_norm_b_g,
          out_norm_g, w_out, norm_ffn_g, w_gate_up, w_down, norm_final_g):
    for l in range(DEPTH):
        x = encoder_layer(x, mem, norm_mix_g[l], norm_mem_g[l], w_in[l], w_mem_kv[l], sink_a[l],
                          q_norm_b_g[l], k_norm_b_g[l], out_norm_g[l], w_out[l], norm_ffn_g[l],
                          w_gate_up[l], w_down[l])
    return rmsnorm(x, norm_final_g)


def setup_inputs(seed: int = 0) -> dict:
    key = jax.random.key(seed)
    ks = jax.random.split(key, 20)
    f32 = jnp.float32

    def normal(k, shape, scale):
        return jax.random.normal(k, shape, f32) * scale

    def gain(k, shape):
        return 1.0 + normal(k, shape, 0.02)

    return {
        "x_prompt": normal(ks[0], (BATCH, SEQ, D_MODEL), 1.0),
        "x_sample": normal(ks[1], (DEC_BATCH, DEC_SEQ, D_MODEL), 1.0),
        "mem_prompt": normal(ks[2], (BATCH, N_MEM, D_MODEL), 1.0),
        "mem_sample": normal(ks[3], (DEC_BATCH, N_MEM, D_MODEL), 1.0),
        "norm_mix_g": gain(ks[4], (DEPTH, D_MODEL)),
        "norm_mem_g": gain(ks[5], (DEPTH, D_MODEL)),
        "w_in": normal(ks[6], (DEPTH, D_MODEL, IN_WIDTH), D_MODEL ** -0.5),
        "w_mem_kv": normal(ks[7], (DEPTH, D_MODEL, MEM_KV_WIDTH), D_MODEL ** -0.5),
        "sink_a": normal(ks[8], (DEPTH, A_HEADS), 0.5),
        "q_norm_b_g": gain(ks[9], (DEPTH, HEAD_DIM)),
        "k_norm_b_g": gain(ks[10], (DEPTH, HEAD_DIM)),
        "out_norm_g": gain(ks[11], (DEPTH, MIX_WIDTH)),
        "w_out": normal(ks[12], (DEPTH, MIX_WIDTH, D_MODEL), MIX_WIDTH ** -0.5),
        "norm_ffn_g": gain(ks[13], (DEPTH, D_MODEL)),
        "w_gate_up": normal(ks[14], (DEPTH, D_MODEL, 2 * D_FF), D_MODEL ** -0.5),
        "w_down": normal(ks[15], (DEPTH, D_FF, D_MODEL), D_FF ** -0.5),
        "norm_final_g": gain(ks[16], (D_MODEL,)),
    }


def reference(x_prompt, x_sample, mem_prompt, mem_sample, norm_mix_g, norm_mem_g, w_in, w_mem_kv,
              sink_a, q_norm_b_g, k_norm_b_g, out_norm_g, w_out, norm_ffn_g, w_gate_up, w_down,
              norm_final_g):
    y_prompt = trunk(x_prompt, mem_prompt, norm_mix_g, norm_mem_g, w_in, w_mem_kv, sink_a, q_norm_b_g,
                     k_norm_b_g, out_norm_g, w_out, norm_ffn_g, w_gate_up, w_down, norm_final_g)
    y_sample = trunk(x_sample, mem_sample, norm_mix_g, norm_mem_g, w_in, w_mem_kv, sink_a, q_norm_b_g,
                     k_norm_b_g, out_norm_g, w_out, norm_ffn_g, w_gate_up, w_down, norm_final_g)
    return (y_prompt, y_sample)
```

```cpp
#include <hip/hip_runtime.h>
#include <hip/hip_cooperative_groups.h>
#include <hip/hip_bf16.h>
#include <cstdio>
#include <cstdint>
#include <cmath>
namespace cg = cooperative_groups;
namespace pg8 {
#define PG8_LAS __attribute__((address_space(3)))
typedef unsigned short bf16_t;
typedef short bf16x8 __attribute__((ext_vector_type(8)));
typedef float f32x4 __attribute__((ext_vector_type(4)));
typedef unsigned u32x4 __attribute__((ext_vector_type(4)));
constexpr int BM = 256, BK = 64, HALF = 128, HTB = HALF * BK * 2  , STAGE_BYTES = 8 * HTB, NXCD = 8, WGM = 8;

__host__ __device__ __forceinline__ int lds_byte(int r, int c) { const int st = (r >> 4) * 2 + (c >> 5), rr = r & 15, cc = c & 31, ob = rr * 64 + cc * 2; return st * 1024 + (ob ^ (((ob >> 9) & 1) << 5)); }
__host__ __device__ __forceinline__ void stage_rc(int b, int& R, int& C) { const int st = b / 1024, sb = b % 1024, swz = sb ^ (((sb >> 9) & 1) << 5); R = (st >> 1) * 16 + swz / 64; C = (st & 1) * 32 + (swz % 64) / 2; }
__host__ __device__ __forceinline__ int perm32(int rho) { const int n = rho >> 4, i = rho & 15; return 8 * (i >> 2) + 4 * n + (i & 3); }

struct Unit { int pm, pn; };
struct Gemm { const bf16_t* A; const bf16_t* Bt; int M, N, K; };

struct StaticOrder {
    int nM, nN, nwg, G, c;
    __host__ __device__ void init(int M, int N, int G_, int c_) { nM = M / BM; nN = N / BM; nwg = nM * nN; G = G_; c = c_; }
    __host__ __device__ bool next(int i, Unit& u) const {
        const long L = (long)i * G + c; if (L >= nwg) return false;
        int wgid = (int)L; { const int q = nwg / NXCD, r = nwg % NXCD, xcd = wgid % NXCD, off = wgid / NXCD; wgid = (xcd < r ? xcd * (q + 1) : r * (q + 1) + (xcd - r) * q) + off; }
        const int nig = WGM * nN, gid = wgid / nig, fm = gid * WGM, gsz = (nM - fm) < WGM ? (nM - fm) : WGM;
        u.pm = fm + ((wgid % nig) % gsz); u.pn = (wgid % nig) / gsz; return true;
    }
    __device__ __forceinline__ void a_ready(const Unit&) const {}
    __device__ __forceinline__ void done(const Unit&) const {}
};

__device__ __forceinline__ unsigned cvt_pk_bf16(float lo, float hi) { unsigned r; asm volatile("v_cvt_pk_bf16_f32 %0, %1, %2" : "=v"(r) : "v"(lo), "v"(hi)); return r; }
typedef float f32x2 __attribute__((ext_vector_type(2)));
template <class Epi, class Sched, bool ALIGN_EPI = false, bool SP2 = false, bool KSEG = false>
__device__ __forceinline__ void gemm_phase(PG8_LAS unsigned char* lds, const Gemm g, const Sched& S, const Epi& E) {
    const int tid = threadIdx.x, wid = __builtin_amdgcn_readfirstlane(tid >> 6), lane = tid & 63, wr = wid >> 2, wc = wid & 3, fr = lane & 15, fq = lane >> 4;
    const int K = g.K, nt = K / BK;
    unsigned voffA[2], voffB[2];
#pragma unroll
    for (int i = 0; i < 2; ++i) { int R, C; stage_rc(tid * 16 + i * 8192, R, C); const int Rb = Epi::PERM ? ((R & ~31) + perm32(R & 31)) : R;
        voffA[i] = (unsigned)(R * K + C) * 2u; voffB[i] = (unsigned)(Rb * K + C) * 2u; }
    const size_t kstep = (size_t)(BK * 2);
    const size_t hstep = (size_t)HALF * K * 2;
    const size_t tstep = 2 * hstep;
    const unsigned ldsw = (unsigned)wid * 1024u;
    const int aoff = lds_byte(wr * 64 + fr, fq * 8), boff = lds_byte(wc * 32 + fr, fq * 8);
#define PG8_SA(b, h) (((b) * 2 + (h)) * HTB)
#define PG8_SB(b, h) ((4 + (b) * 2 + (h)) * HTB)
#define PG8_STAGE(bufoff, gbase, voff) do { _Pragma("unroll") for (int _i = 0; _i < 2; ++_i) \
        __builtin_amdgcn_global_load_lds((const unsigned*)((const char*)(gbase) + (voff)[_i]), (PG8_LAS unsigned*)(lds + (bufoff) + ldsw + _i * 8192), 16, 0, 0); } while (0)
#define PG8_LDA(dst, b, h) do { _Pragma("unroll") for (int m = 0; m < 4; ++m) _Pragma("unroll") for (int k = 0; k < 2; ++k) dst[m][k] = *(const PG8_LAS bf16x8*)(lds + PG8_SA(b, h) + aoff + m * 2048 + k * 1024); } while (0)
#define PG8_LDB(dst, b, h) do { _Pragma("unroll") for (int n = 0; n < 2; ++n) _Pragma("unroll") for (int k = 0; k < 2; ++k) dst[n][k] = *(const PG8_LAS bf16x8*)(lds + PG8_SB(b, h) + boff + n * 2048 + k * 1024); } while (0)
#define PG8_MMA(ai, bj, At, Bt) do { __builtin_amdgcn_s_setprio(1); _Pragma("unroll") for (int m = 0; m < 4; ++m) _Pragma("unroll") for (int n = 0; n < 2; ++n) _Pragma("unroll") for (int k = 0; k < 2; ++k) \
        acc[ai][bj][m][n] = __builtin_amdgcn_mfma_f32_16x16x32_bf16(Bt[n][k], At[m][k], acc[ai][bj][m][n], 0, 0, 0); __builtin_amdgcn_s_setprio(0); } while (0)
#define PG8_WAIT_V(n) asm volatile("s_waitcnt vmcnt(" #n ")" ::: "memory")
#define PG8_WAIT_L(n) asm volatile("s_waitcnt lgkmcnt(" #n ")" ::: "memory")
#define PG8_BAR __builtin_amdgcn_s_barrier()
#define PG8_SCHED __builtin_amdgcn_sched_barrier(0)
    Unit cur, nxt; int ui = 0;
    if (!S.next(0, cur)) return;
    f32x4 acc[2][2][4][2];
#pragma unroll
    for (int a = 0; a < 2; ++a)
#pragma unroll
        for (int b = 0; b < 2; ++b)
#pragma unroll
            for (int m = 0; m < 4; ++m)
#pragma unroll
                for (int n = 0; n < 2; ++n) acc[a][b][m][n] = (f32x4){0.f, 0.f, 0.f, 0.f};
    bf16x8 At[4][2], B0[2][2], B1[2][2];
    const char* cA = (const char*)g.A + (size_t)cur.pm * tstep; const char* cB = (const char*)g.Bt + (size_t)cur.pn * tstep;
    S.a_ready(cur);
    if constexpr (SP2) {
        PG8_STAGE(PG8_SB(0, 0), cB, voffB); PG8_STAGE(PG8_SB(0, 1), cB + hstep, voffB); PG8_STAGE(PG8_SA(0, 0), cA, voffA); PG8_STAGE(PG8_SA(0, 1), cA + hstep, voffA);
        if (wr == 1) PG8_BAR;
        PG8_WAIT_V(2); PG8_BAR;
        PG8_STAGE(PG8_SB(1, 0), cB + kstep, voffB); PG8_STAGE(PG8_SA(1, 0), cA + kstep, voffA); PG8_STAGE(PG8_SB(1, 1), cB + hstep + kstep, voffB);
        PG8_WAIT_V(6); PG8_BAR;
    } else {
        PG8_STAGE(PG8_SB(0, 0), cB, voffB); PG8_STAGE(PG8_SA(0, 0), cA, voffA); PG8_STAGE(PG8_SB(0, 1), cB + hstep, voffB); PG8_STAGE(PG8_SA(0, 1), cA + hstep, voffA);
        if (wr == 1) PG8_BAR;
        PG8_WAIT_V(4); PG8_BAR;
        PG8_STAGE(PG8_SB(1, 0), cB + kstep, voffB); PG8_STAGE(PG8_SA(1, 0), cA + kstep, voffA); PG8_STAGE(PG8_SB(1, 1), cB + hstep + kstep, voffB);
        PG8_WAIT_V(6); PG8_BAR;
    }
    for (;;) {
        const bool has_next = S.next(ui + 1, nxt);
        const char* nA = has_next ? (const char*)g.A + (size_t)nxt.pm * tstep : cA; const char* nB = has_next ? (const char*)g.Bt + (size_t)nxt.pn * tstep : cB;
        for (int t = 0; t < nt; t += 2) {
            const bool last = (t == nt - 2);
            const char* a1 = cA + (size_t)(t + 1) * kstep;
            const char* a2 = last ? nA : cA + (size_t)(t + 2) * kstep; const char* b2 = last ? nB : cB + (size_t)(t + 2) * kstep;
            const char* a3 = a2 + kstep; const char* b3 = b2 + kstep;
            if (last && has_next) S.a_ready(nxt);
            if constexpr (SP2) {
            PG8_LDB(B0, 0, 0); PG8_LDB(B1, 0, 1); PG8_SCHED; PG8_LDA(At, 0, 0); PG8_STAGE(PG8_SA(1, 1), a1 + hstep, voffA);
            PG8_WAIT_V(8); PG8_WAIT_L(0); PG8_BAR; PG8_MMA(0, 0, At, B0); PG8_MMA(0, 1, At, B1); PG8_BAR; PG8_SCHED;
            PG8_LDA(At, 0, 1); PG8_STAGE(PG8_SB(0, 0), b2, voffB); PG8_STAGE(PG8_SB(0, 1), b2 + hstep, voffB); PG8_STAGE(PG8_SA(0, 0), a2, voffA);
            PG8_WAIT_V(8); PG8_WAIT_L(0); PG8_BAR; PG8_MMA(1, 0, At, B0); PG8_MMA(1, 1, At, B1); PG8_BAR; PG8_SCHED;
            PG8_LDB(B0, 1, 0); PG8_LDB(B1, 1, 1); PG8_SCHED; PG8_LDA(At, 1, 0); PG8_STAGE(PG8_SA(0, 1), a2 + hstep, voffA);
            PG8_WAIT_V(8); PG8_WAIT_L(0); PG8_BAR; PG8_MMA(0, 0, At, B0); PG8_MMA(0, 1, At, B1); PG8_BAR; PG8_SCHED;
            PG8_LDA(At, 1, 1); PG8_STAGE(PG8_SB(1, 0), b3, voffB); PG8_STAGE(PG8_SB(1, 1), b3 + hstep, voffB); PG8_STAGE(PG8_SA(1, 0), a3, voffA);
            PG8_WAIT_V(8); PG8_WAIT_L(0); PG8_BAR; PG8_MMA(1, 0, At, B0); PG8_MMA(1, 1, At, B1); PG8_BAR; PG8_SCHED;
            } else {
            PG8_LDB(B0, 0, 0); PG8_SCHED; PG8_LDA(At, 0, 0); PG8_STAGE(PG8_SA(1, 1), a1 + hstep, voffA);
            PG8_WAIT_L(8); PG8_BAR; PG8_WAIT_L(0); PG8_MMA(0, 0, At, B0); PG8_BAR; PG8_SCHED;
            PG8_LDB(B1, 0, 1); PG8_STAGE(PG8_SB(0, 0), b2, voffB);
            PG8_BAR; PG8_WAIT_L(0); PG8_MMA(0, 1, At, B1); PG8_BAR;
            PG8_LDA(At, 0, 1); PG8_STAGE(PG8_SA(0, 0), a2, voffA);
            PG8_BAR; PG8_WAIT_L(0); PG8_MMA(1, 0, At, B0); PG8_BAR; PG8_SCHED;
            PG8_STAGE(PG8_SB(0, 1), b2 + hstep, voffB);
            PG8_WAIT_V(6); PG8_BAR; PG8_MMA(1, 1, At, B1); PG8_BAR;
            PG8_LDB(B0, 1, 0); PG8_SCHED; PG8_LDA(At, 1, 0); PG8_STAGE(PG8_SA(0, 1), a2 + hstep, voffA);
            PG8_WAIT_L(8); PG8_BAR; PG8_WAIT_L(0); PG8_MMA(0, 0, At, B0); PG8_BAR; PG8_SCHED;
            PG8_LDB(B1, 1, 1); PG8_STAGE(PG8_SB(1, 0), b3, voffB);
            PG8_BAR; PG8_WAIT_L(0); PG8_MMA(0, 1, At, B1); PG8_BAR;
            PG8_LDA(At, 1, 1); PG8_STAGE(PG8_SA(1, 0), a3, voffA);
            PG8_BAR; PG8_WAIT_L(0); PG8_MMA(1, 0, At, B0); PG8_BAR; PG8_SCHED;
            PG8_STAGE(PG8_SB(1, 1), b3 + hstep, voffB);
            PG8_WAIT_V(6); PG8_BAR; PG8_MMA(1, 1, At, B1); PG8_BAR;
            }
            if constexpr (KSEG) { if (t == 14 || t == 22) E.kscale(acc, ui, t == 14 ? 0 : 1, wr, fr); }
        }
        if constexpr (ALIGN_EPI) { if (wr == 0) PG8_BAR; }
        if constexpr (!Epi::AFTER_DRAIN) { if constexpr (KSEG) E.final(acc, cur, ui, wr, wc, fr, fq); else E(acc, cur, wr, wc, fr, fq); S.done(cur); }
        if (!has_next) break;
#pragma unroll
        for (int a = 0; a < 2; ++a)
#pragma unroll
            for (int b = 0; b < 2; ++b)
#pragma unroll
                for (int m = 0; m < 4; ++m)
#pragma unroll
                    for (int n = 0; n < 2; ++n) acc[a][b][m][n] = (f32x4){0.f, 0.f, 0.f, 0.f};
        cur = nxt; cA = nA; cB = nB; ++ui;
        if constexpr (ALIGN_EPI) { if (wr == 1) PG8_BAR; }
    }
    PG8_WAIT_V(0);
    if constexpr (!ALIGN_EPI) { if (wr == 0) PG8_BAR; }
    PG8_BAR;
    if constexpr (Epi::AFTER_DRAIN) { E.fused(acc, cur, wr, wc, fr, fq, lds, wid, lane); S.done(cur); }
#undef PG8_SA
#undef PG8_SB
#undef PG8_STAGE
#undef PG8_LDA
#undef PG8_LDB
#undef PG8_MMA
#undef PG8_WAIT_V
#undef PG8_WAIT_L
#undef PG8_BAR
#undef PG8_SCHED
}
}
namespace att {
using bf16 = __hip_bfloat16;
constexpr int   D = 128, NW = 8, QBLK = 32, KVBLK = 64;
constexpr float SCALE = 0.088388347648318440f;
constexpr float THR = 8.f;
constexpr size_t SHM_V = KVBLK * D * 2, SHM_K = KVBLK * D * 2, SHM_ATTN = 2 * SHM_V + 2 * SHM_K + NW * 64 * 4;
using bf16x8 = __attribute__((ext_vector_type(8))) short;
using s16x4  = __attribute__((ext_vector_type(4))) short;
using f32x16 = __attribute__((ext_vector_type(16))) float;
using f32x8  = __attribute__((ext_vector_type(8))) float;
using u32x4  = __attribute__((ext_vector_type(4))) unsigned;
#define KSWZ(row, colB) ((row) * 256 + ((colB) ^ (((row) & 7) << 4)))
#define SBAR() __builtin_amdgcn_sched_barrier(0)
__device__ __forceinline__ int crow(int r, int hi) { return (r & 3) + 8 * (r >> 2) + 4 * hi; }
__device__ __forceinline__ unsigned cvtpk(float lo, float hi) {
  unsigned r; asm volatile("v_cvt_pk_bf16_f32 %0, %1, %2" : "=v"(r) : "v"(lo), "v"(hi)); return r;
}
template <typename TIn> struct Stage;
template <> struct Stage<bf16>  { using T = bf16x8;
  __device__ static __forceinline__ T ld8(const bf16* p) { return *reinterpret_cast<const bf16x8*>(p); }
  __device__ static __forceinline__ bf16x8 tobf(T x) { return x; } };
template <> struct Stage<float> { using T = f32x8;
  __device__ static __forceinline__ T ld8(const float* p) { return *reinterpret_cast<const f32x8*>(p); }
  __device__ static __forceinline__ bf16x8 tobf(T x) {
    u32x4 w = {cvtpk(x[0], x[1]), cvtpk(x[2], x[3]), cvtpk(x[4], x[5]), cvtpk(x[6], x[7])}; return *reinterpret_cast<bf16x8*>(&w); } };

__device__ __forceinline__ void partialSM(f32x16& p0, f32x16& p1, float& m_reg, float& mn, float& alpha) {
  constexpr float C = SCALE * 1.4426950408889634f;
  float pmax = p0[0]; for (int r = 1; r < 16; ++r) pmax = fmaxf(pmax, p0[r]); for (int r = 0; r < 16; ++r) pmax = fmaxf(pmax, p1[r]);
  { auto rr = __builtin_amdgcn_permlane32_swap(__float_as_uint(pmax), __float_as_uint(pmax), false, false);
    pmax = fmaxf(__uint_as_float(rr[0]), __uint_as_float(rr[1])); }
  if (__builtin_expect(__all(pmax - m_reg <= THR / SCALE), 1)) { mn = m_reg; alpha = 1.f; }
  else { mn = fmaxf(m_reg, pmax); alpha = __builtin_amdgcn_exp2f((m_reg - mn) * C); m_reg = mn; }
  float mnC = -mn * C;
  for (int r = 0; r < 16; ++r) p0[r] = fmaf(p0[r], C, mnC); for (int r = 0; r < 16; ++r) p1[r] = fmaf(p1[r], C, mnC);
  for (int r = 0; r < 16; ++r) p0[r] = __builtin_amdgcn_exp2f(p0[r]);
}
__device__ __forceinline__ float psm_max0(const f32x16& p0) { float a = p0[0]; for (int r = 1; r < 16; ++r) a = fmaxf(a, p0[r]); return a; }
__device__ __forceinline__ void psm_decide(float pmax, const f32x16& p1, float& m_reg, float& mn, float& alpha) {
  constexpr float C = SCALE * 1.4426950408889634f;
  for (int r = 0; r < 16; ++r) pmax = fmaxf(pmax, p1[r]);
  { auto rr = __builtin_amdgcn_permlane32_swap(__float_as_uint(pmax), __float_as_uint(pmax), false, false);
    pmax = fmaxf(__uint_as_float(rr[0]), __uint_as_float(rr[1])); }
  if (__builtin_expect(__all(pmax - m_reg <= THR / SCALE), 1)) { mn = m_reg; alpha = 1.f; }
  else { mn = fmaxf(m_reg, pmax); alpha = __builtin_amdgcn_exp2f((m_reg - mn) * C); m_reg = mn; }
}
__device__ __forceinline__ void psm_scale(f32x16& p0, f32x16& p1, float mn) {
  constexpr float C = SCALE * 1.4426950408889634f; const float mnC = -mn * C;
  for (int r = 0; r < 16; ++r) p0[r] = fmaf(p0[r], C, mnC); for (int r = 0; r < 16; ++r) p1[r] = fmaf(p1[r], C, mnC);
}
__device__ __forceinline__ void psm_exp0(f32x16& p0) { for (int r = 0; r < 16; ++r) p0[r] = __builtin_amdgcn_exp2f(p0[r]); }
__device__ __forceinline__ void finishSM(f32x16& p0, f32x16& p1, float alpha, float& l_reg, bf16x8& pa0, bf16x8& pa1, bf16x8& pa2, bf16x8& pa3) {
  for (int r = 0; r < 16; ++r) p1[r] = __builtin_amdgcn_exp2f(p1[r]);
  float ps = 0; for (int r = 0; r < 16; ++r) ps += p0[r]; for (int r = 0; r < 16; ++r) ps += p1[r];
  { auto rr = __builtin_amdgcn_permlane32_swap(__float_as_uint(ps), __float_as_uint(ps), false, false);
    ps = __uint_as_float(rr[0]) + __uint_as_float(rr[1]); }
  l_reg = l_reg * alpha + ps;
#define PK4(P, BASE, OUT) do { unsigned a0 = cvtpk(P[BASE + 0], P[BASE + 1]), a1 = cvtpk(P[BASE + 2], P[BASE + 3]);   \
    unsigned b0 = cvtpk(P[BASE + 4], P[BASE + 5]), b1 = cvtpk(P[BASE + 6], P[BASE + 7]);                              \
    auto r0 = __builtin_amdgcn_permlane32_swap(a0, b0, false, false); auto r1 = __builtin_amdgcn_permlane32_swap(a1, b1, false, false); \
    u32x4 w = {r0[0], r1[0], r0[1], r1[1]}; OUT = *reinterpret_cast<bf16x8*>(&w); } while (0)
  PK4(p0, 0, pa0); PK4(p0, 8, pa1); PK4(p1, 0, pa2); PK4(p1, 8, pa3);
#undef PK4
}
__device__ __forceinline__ void qkt(f32x16& p0, f32x16& p1, const bf16* Ks, const bf16x8* qr, int r32, int hi) {
  p0 = f32x16{}; p1 = f32x16{};
  for (int d0 = 0; d0 < 8; ++d0) { int cb = (d0 * 16 + hi * 8) * 2;
    bf16x8 b0 = *reinterpret_cast<const bf16x8*>((const char*)Ks + KSWZ(r32, cb));
    bf16x8 b1 = *reinterpret_cast<const bf16x8*>((const char*)Ks + KSWZ(32 + r32, cb));
    p0 = __builtin_amdgcn_mfma_f32_32x32x16_bf16(b0, qr[d0], p0, 0, 0, 0);
    p1 = __builtin_amdgcn_mfma_f32_32x32x16_bf16(b1, qr[d0], p1, 0, 0, 0); }
}
__device__ __forceinline__ int v_st(int k, int c) { const int kk = (k & ~0xC) | ((k & 4) << 1) | ((k & 8) >> 1); return ((kk >> 3) * 4 + (c >> 5)) * 512 + ((kk & 7) * 32 + (c & 31)) * 2; }
__device__ __forceinline__ int v_rd_base(int lane) { return ((lane & 3) << 3) | (((lane >> 2) & 3) << 6) | (((lane >> 4) & 1) << 5) | (((lane >> 5) & 1) << 8); }
constexpr int v_rd_off(int d0, int ks, int half) { return d0 * 512 + ks * 4096 + half * 2048; }
template <int OFF> __device__ __forceinline__ s16x4 tr_read(int vb) {
  s16x4 r; asm volatile("ds_read_b64_tr_b16 %0, %1 offset:%2" : "=&v"(r) : "v"(vb), "i"(OFF) : "memory"); return r;
}
template <int D0> __device__ __forceinline__ void pv_one(f32x16& od, int vb, bf16x8 pa0, bf16x8 pa1, bf16x8 pa2, bf16x8 pa3) {
  const s16x4 l0 = tr_read<v_rd_off(D0, 0, 0)>(vb), h0 = tr_read<v_rd_off(D0, 0, 1)>(vb), l1 = tr_read<v_rd_off(D0, 1, 0)>(vb), h1 = tr_read<v_rd_off(D0, 1, 1)>(vb);
  const s16x4 l2 = tr_read<v_rd_off(D0, 2, 0)>(vb), h2 = tr_read<v_rd_off(D0, 2, 1)>(vb), l3 = tr_read<v_rd_off(D0, 3, 0)>(vb), h3 = tr_read<v_rd_off(D0, 3, 1)>(vb);
  asm volatile("s_waitcnt lgkmcnt(0)" ::: "memory"); SBAR();
#define PK(L, H) (bf16x8){L[0], L[1], L[2], L[3], H[0], H[1], H[2], H[3]}
  od = __builtin_amdgcn_mfma_f32_32x32x16_bf16(pa0, PK(l0, h0), od, 0, 0, 0);
  od = __builtin_amdgcn_mfma_f32_32x32x16_bf16(pa1, PK(l1, h1), od, 0, 0, 0);
  od = __builtin_amdgcn_mfma_f32_32x32x16_bf16(pa2, PK(l2, h2), od, 0, 0, 0);
  od = __builtin_amdgcn_mfma_f32_32x32x16_bf16(pa3, PK(l3, h3), od, 0, 0, 0);
#undef PK
}
__device__ __forceinline__ void pv_d0(f32x16* o, int vb, bf16x8 pa0, bf16x8 pa1, bf16x8 pa2, bf16x8 pa3) {
  pv_one<0>(o[0], vb, pa0, pa1, pa2, pa3); pv_one<1>(o[1], vb, pa0, pa1, pa2, pa3); pv_one<2>(o[2], vb, pa0, pa1, pa2, pa3); pv_one<3>(o[3], vb, pa0, pa1, pa2, pa3);
}
__device__ __forceinline__ void maskwin(f32x16& p0, f32x16& p1, int mb) {
#pragma unroll
  for (int r = 0; r < 16; ++r) { const int dk = mb + (r & 3) + 8 * (r >> 2);
    if ((unsigned)dk > 256u) p0[r] = -INFINITY; if ((unsigned)(dk + 32) > 256u) p1[r] = -INFINITY; }
}
constexpr int LDQ = 3072, LDO = 2048;
using f32x4 = __attribute__((ext_vector_type(4))) float;
__device__ __forceinline__ float bf2f(short v) { return __builtin_bit_cast(float, ((unsigned)(unsigned short)v) << 16); }
__device__ __forceinline__ void sincos_fast(float ang, float& sn, float& cs) { const float f = __builtin_amdgcn_fractf(ang * 0.15915494309189535f); sn = __builtin_amdgcn_sinf(f); cs = __builtin_amdgcn_cosf(f); }
template <int MODE, int QMODE>
__device__ __forceinline__ void attn_body(const bf16* __restrict__ Qb, const bf16* __restrict__ Kh, const bf16* __restrict__ Vh,
                                          unsigned short* __restrict__ Ob, float* __restrict__ hsp, int seq, int ldk, int qrel, const float* __restrict__ sinkp, int t0, const float* __restrict__ qg, char* lds) {
  using St = Stage<bf16>;
  int tid = threadIdx.x; asm volatile("" : "+v"(tid));
  const int wid = __builtin_amdgcn_readfirstlane(tid >> 6), lane = tid & 63, r32 = lane & 31, hi = lane >> 5;
  const int wrow = MODE ? (wid & 3) * QBLK : wid * QBLK, wcol = MODE ? (wid >> 2) * D : 0;
  bf16* V_lds = (bf16*)lds; bf16* K_lds = (bf16*)(lds + 2 * SHM_V);
  float* ws = (float*)(lds + 2 * SHM_V + 2 * SHM_K) + wid * 64; float* li_l = ws; float* al_l = ws + 32;
  float m_reg = MODE ? sinkp[wid >> 2] * (1.0f / SCALE) : -1e30f, l_reg = MODE ? 1.f : 0.f; bf16x8 qr[8];
  const bf16* Qw = Qb + (long)(wrow + r32) * LDQ + wcol + hi * 8;
#pragma unroll
  for (int d0 = 0; d0 < 8; ++d0) qr[d0] = St::ld8(Qw + d0 * 16);
  if constexpr (QMODE != 0) {
    const int t = t0 + wrow + r32; constexpr float L2T = 13.287712379549449f;
    if constexpr (QMODE == 2) {
      float ssq = 0.f;
#pragma unroll
      for (int d0 = 0; d0 < 8; ++d0)
#pragma unroll
        for (int j = 0; j < 8; ++j) { const float x = bf2f(qr[d0][j]); ssq += x * x; }
      { auto rr = __builtin_amdgcn_permlane32_swap(__float_as_uint(ssq), __float_as_uint(ssq), false, false); ssq = __uint_as_float(rr[0]) + __uint_as_float(rr[1]); }
      const float rn = 1.0f / sqrtf(ssq * (1.0f / 128.0f) + 1e-6f);
      const float posr = (float)(t >> 6), posc = (float)(t & 63);
#pragma unroll
      for (int hf = 0; hf < 2; ++hf)
#pragma unroll
        for (int dd = 0; dd < 2; ++dd) { const int da = hf * 4 + dd, db = da + 2;
          const f32x4 ga0 = *(const f32x4*)(qg + da * 16 + hi * 8), ga1 = *(const f32x4*)(qg + da * 16 + hi * 8 + 4), gb0 = *(const f32x4*)(qg + db * 16 + hi * 8), gb1 = *(const f32x4*)(qg + db * 16 + hi * 8 + 4);
          float ya[8], yb[8];
#pragma unroll
          for (int j = 0; j < 8; ++j) { const int i = dd * 16 + hi * 8 + j; const float inv = __builtin_amdgcn_exp2f(-(float)i * (L2T / 32.0f));
            float sn, cs; sincos_fast((hf ? posc : posr) * inv, sn, cs);
            const float x1 = bf2f(qr[da][j]) * rn * (j < 4 ? ga0[j & 3] : ga1[j & 3]), x2 = bf2f(qr[db][j]) * rn * (j < 4 ? gb0[j & 3] : gb1[j & 3]);
            ya[j] = x1 * cs - x2 * sn; yb[j] = x2 * cs + x1 * sn; }
          u32x4 wa = {cvtpk(ya[0], ya[1]), cvtpk(ya[2], ya[3]), cvtpk(ya[4], ya[5]), cvtpk(ya[6], ya[7])}, wb = {cvtpk(yb[0], yb[1]), cvtpk(yb[2], yb[3]), cvtpk(yb[4], yb[5]), cvtpk(yb[6], yb[7])};
          qr[da] = *reinterpret_cast<bf16x8*>(&wa); qr[db] = *reinterpret_cast<bf16x8*>(&wb); SBAR(); }
    } else {
      const float pos = (float)t;
#pragma unroll
      for (int d0 = 0; d0 < 4; ++d0) { float ya[8], yb[8];
#pragma unroll
        for (int j = 0; j < 8; ++j) { const int i = d0 * 16 + hi * 8 + j; const float inv = __builtin_amdgcn_exp2f(-(float)i * (L2T / 64.0f));
          float sn, cs; sincos_fast(pos * inv, sn, cs);
          const float x1 = bf2f(qr[d0][j]), x2 = bf2f(qr[d0 + 4][j]);
          ya[j] = x1 * cs - x2 * sn; yb[j] = x2 * cs + x1 * sn; }
        u32x4 wa = {cvtpk(ya[0], ya[1]), cvtpk(ya[2], ya[3]), cvtpk(ya[4], ya[5]), cvtpk(ya[6], ya[7])}, wb = {cvtpk(yb[0], yb[1]), cvtpk(yb[2], yb[3]), cvtpk(yb[4], yb[5]), cvtpk(yb[6], yb[7])};
        qr[d0] = *reinterpret_cast<bf16x8*>(&wa); qr[d0 + 4] = *reinterpret_cast<bf16x8*>(&wb); SBAR(); }
    }
  }
#pragma unroll
  for (int d0 = 0; d0 < 8; ++d0) asm volatile("" : "+v"(qr[d0]));
  asm volatile("" ::: "memory"); SBAR();
  f32x16 o[4] = {};
  const int sr = tid >> 4, sc = (tid & 15) * 8, vst0 = v_st(sr, sc), vst1 = v_st(32 + sr, sc);
  const int vb0 = (int)(uintptr_t)V_lds + v_rd_base(lane);
  const unsigned toff = (unsigned)(sr * ldk + sc) * 2u; const long h32 = (long)ldk * 64;
  constexpr int SDEPTH = (MODE == 0 && QMODE == 2) ? 2 : 1;
  struct { typename St::T vs0, vs1, ks0, ks1; } sr_[SDEPTH];
#define SLOAD(i, k0) do { const long to_ = (long)(k0) * ldk * 2; const char* vt_ = (const char*)Vh + to_; const char* kt_ = (const char*)Kh + to_; \
    sr_[i].vs0 = *(const bf16x8*)(vt_ + toff); sr_[i].vs1 = *(const bf16x8*)(vt_ + h32 + toff); \
    sr_[i].ks0 = *(const bf16x8*)(kt_ + toff); sr_[i].ks1 = *(const bf16x8*)(kt_ + h32 + toff); } while (0)
#define SWRITE(b, i) do { *(bf16x8*)((char*)V_lds + (b) * SHM_V + vst0) = St::tobf(sr_[i].vs0);          \
    *(bf16x8*)((char*)V_lds + (b) * SHM_V + vst1) = St::tobf(sr_[i].vs1); int kc = sc * 2;               \
    *(bf16x8*)((char*)K_lds + (b) * SHM_K + KSWZ(sr, kc)) = St::tobf(sr_[i].ks0);                       \
    *(bf16x8*)((char*)K_lds + (b) * SHM_K + KSWZ(32 + sr, kc)) = St::tobf(sr_[i].ks1); } while (0)
#define SWAIT() do { if constexpr (SDEPTH == 2) asm volatile("s_waitcnt vmcnt(4)" ::: "memory"); else asm volatile("s_waitcnt vmcnt(0)" ::: "memory"); } while (0)
#define RESC(a) do { if (__any((a) < 1.f)) { if (hi == 0) al_l[r32] = (a); asm volatile("s_waitcnt lgkmcnt(0)" ::: "memory"); \
    for (int d = 0; d < 4; ++d) for (int r = 0; r < 16; ++r) o[d][r] *= al_l[crow(r, hi)]; } } while (0)
  const int qw0 = qrel + wrow;
#define MASK(P0, P1, k0) do { if constexpr (MODE == 1) { const int k0_ = (k0); \
    if ((k0_ + 63 - qw0 > 128) || (k0_ - (qw0 + 31) < -128)) maskwin(P0, P1, k0_ - (qw0 + r32) + 128 + 4 * hi); } } while (0)
#define PVSM(VB, P0, P1, K0, MN, AL) do { MASK(P0, P1, K0); float pm_; \
    pv_one<0>(o[0], VB, pa0, pa1, pa2, pa3); pm_ = psm_max0(P0); \
    pv_one<1>(o[1], VB, pa0, pa1, pa2, pa3); psm_decide(pm_, P1, m_reg, MN, AL); \
    pv_one<2>(o[2], VB, pa0, pa1, pa2, pa3); psm_scale(P0, P1, MN); asm volatile("" : "+v"(P0), "+v"(P1)); \
    pv_one<3>(o[3], VB, pa0, pa1, pa2, pa3); psm_exp0(P0); asm volatile("" : "+v"(P0)); SBAR(); } while (0)
  if (wid >= 4) __builtin_amdgcn_s_setprio(1);
  f32x16 pA0, pA1, pB0, pB1; float mnA, mnB, alA, alB; bf16x8 pa0, pa1, pa2, pa3; const int NT = seq / KVBLK;
  constexpr int SE = 0, SO = SDEPTH - 1;
  SLOAD(SE, 0); asm volatile("s_waitcnt vmcnt(0)" ::: "memory"); SWRITE(0, SE); __syncthreads();
  qkt(pA0, pA1, K_lds, qr, r32, hi); MASK(pA0, pA1, 0); partialSM(pA0, pA1, m_reg, mnA, alA);
  SLOAD(SO, KVBLK); if constexpr (SDEPTH == 2) { if (2 < NT) SLOAD(SE, 2 * KVBLK); }
  SWAIT(); SWRITE(1, SO); __syncthreads();
  for (int j = 1; j + 1 < NT; j += 2) {
    SBAR(); qkt(pB0, pB1, (bf16*)((char*)K_lds + SHM_K), qr, r32, hi);
    finishSM(pA0, pA1, alA, l_reg, pa0, pa1, pa2, pa3); SBAR();
    SLOAD(SO, (j + SDEPTH) * KVBLK); SBAR();
    PVSM(vb0, pB0, pB1, j * KVBLK, mnB, alB);
    __syncthreads(); SWAIT(); SWRITE(0, SE);
    RESC(alB); __syncthreads();
    SBAR(); qkt(pA0, pA1, K_lds, qr, r32, hi);
    finishSM(pB0, pB1, alB, l_reg, pa0, pa1, pa2, pa3); SBAR();
    if (SDEPTH == 1 || j + 3 < NT) SLOAD(SE, (j + 1 + SDEPTH) * KVBLK); SBAR();
    PVSM(vb0 + (int)SHM_V, pA0, pA1, (j + 1) * KVBLK, mnA, alA);
    __syncthreads(); SWAIT(); SWRITE(1, SO);
    RESC(alA); __syncthreads();
  }
  SBAR(); qkt(pB0, pB1, (bf16*)((char*)K_lds + SHM_K), qr, r32, hi);
  finishSM(pA0, pA1, alA, l_reg, pa0, pa1, pa2, pa3); SBAR();
  PVSM(vb0, pB0, pB1, (NT - 1) * KVBLK, mnB, alB);
  __syncthreads(); RESC(alB);
  finishSM(pB0, pB1, alB, l_reg, pa0, pa1, pa2, pa3); SBAR();
  pv_d0(o, vb0 + (int)SHM_V, pa0, pa1, pa2, pa3);
  __builtin_amdgcn_s_setprio(0);
  if (hi == 0) li_l[r32] = l_reg; asm volatile("s_waitcnt lgkmcnt(0)" ::: "memory");
  float rli[16];
#pragma unroll
  for (int r = 0; r < 16; ++r) rli[r] = __builtin_amdgcn_rcpf(li_l[crow(r, hi)]);
  unsigned zz_ = 0u; asm volatile("" : "+v"(zz_)); const int r32e = (int)__builtin_amdgcn_mbcnt_hi(~0u, __builtin_amdgcn_mbcnt_lo(~0u, zz_)) & 31;
  unsigned short* Ow = Ob + (long)wrow * LDO + wcol + r32e;
#pragma unroll
  for (int r = 0; r < 16; ++r) { int orow = crow(r, hi);
#pragma unroll
    for (int d0 = 0; d0 < 4; ++d0) { const float v = o[d0][r] * rli[r]; Ow[(long)orow * LDO + d0 * 32] = (unsigned short)(cvtpk(v, v) & 0xffffu); o[d0][r] = v * v; } }
  { float* hw = hsp + (long)wrow * 16 + (MODE ? (wid >> 2) : 0);
#pragma unroll
    for (int r = 0; r < 16; ++r) { float q = (o[0][r] + o[1][r]) + (o[2][r] + o[3][r]);
      q += __builtin_bit_cast(float, __builtin_amdgcn_update_dpp(0, __builtin_bit_cast(int, q), 0xB1, 0xF, 0xF, true));
      q += __builtin_bit_cast(float, __builtin_amdgcn_update_dpp(0, __builtin_bit_cast(int, q), 0x4E, 0xF, 0xF, true));
      q += __builtin_bit_cast(float, __builtin_amdgcn_update_dpp(0, __builtin_bit_cast(int, q), 0x141, 0xF, 0xF, true));
      q += __builtin_bit_cast(float, __builtin_amdgcn_update_dpp(0, __builtin_bit_cast(int, q), 0x140, 0xF, 0xF, true));
      { float q2 = q; asm volatile("" : "+v"(q2)); auto rr = __builtin_amdgcn_permlane16_swap(__float_as_uint(q), __float_as_uint(q2), false, false); const unsigned a_ = rr[0], b_ = rr[1]; q = __uint_as_float(a_) + __uint_as_float(b_); }
      if (r32e == r) hw[(long)crow(r, hi) * 16] = q; } }
  __syncthreads();
#undef SLOAD
#undef SWRITE
#undef SWAIT
#undef RESC
#undef MASK
#undef PVSM
}
#undef KSWZ
#undef SBAR
}
#define LAS __attribute__((address_space(3)))
typedef unsigned short bf16_t;
typedef unsigned v4u __attribute__((ext_vector_type(4)));
typedef unsigned v2u __attribute__((ext_vector_type(2)));
typedef float f32x4 __attribute__((ext_vector_type(4)));
constexpr int MTOK = 32768, DM = 2048, INW = 3072, DFF = 5632, NGU = 2 * DFF, MEMR = 768, MKV = 1024, NWAVES = 8;
constexpr int SEQ0 = 16384, SEQS = 8192;
constexpr float EPS = 1e-6f;
constexpr size_t MiB = 1u << 20;
constexpr size_t WS_RSTD1 = 0, WS_SS2 = 128 * 1024, WS_SS3 = 256 * 1024, WS_RSTDM = 384 * 1024;
constexpr size_t WS_WIN = 2 * MiB, WS_WMEM = 14 * MiB, WS_WOUT = 18 * MiB, WS_WGU = 26 * MiB, WS_WD = 70 * MiB;
constexpr size_t WS_KVM = 92 * MiB, WS_MEMB = 94 * MiB;
constexpr size_t WS_XB = 98 * MiB;
constexpr size_t WS_PROJ = 226 * MiB;
constexpr size_t WS_X1B = 290 * MiB;
constexpr size_t WS_HS = 418 * MiB;
constexpr size_t WS_END = 420 * MiB;
constexpr int LDS_BYTES = 147456;

__device__ __forceinline__ unsigned f2bf(float f) { unsigned u = __builtin_bit_cast(unsigned, f); return (u + 0x7fffu + ((u >> 16) & 1u)) >> 16; }
__device__ __forceinline__ unsigned pk2(float lo, float hi) { return pg8::cvt_pk_bf16(lo, hi); }
__device__ __forceinline__ float bflo(unsigned w) { return __builtin_bit_cast(float, w << 16); }
__device__ __forceinline__ float bfhi(unsigned w) { return __builtin_bit_cast(float, w & 0xffff0000u); }
__device__ __forceinline__ float wave_sum(float v) {
#pragma unroll
    for (int o = 1; o < 64; o <<= 1) v += __shfl_xor(v, o);
    return v;
}
template <int CTRL> __device__ __forceinline__ float dppf(float v) { return __builtin_bit_cast(float, __builtin_amdgcn_update_dpp(0, __builtin_bit_cast(int, v), CTRL, 0xF, 0xF, true)); }
__device__ __forceinline__ float sum_x16(float v) { float v2 = v; asm volatile("" : "+v"(v2));
    auto rr = __builtin_amdgcn_permlane16_swap(__builtin_bit_cast(unsigned, v), __builtin_bit_cast(unsigned, v2), false, false); const unsigned a_ = rr[0], b_ = rr[1]; return __uint_as_float(a_) + __uint_as_float(b_); }
__device__ __forceinline__ float sum_x32(float v) { float v2 = v; asm volatile("" : "+v"(v2));
    auto rr = __builtin_amdgcn_permlane32_swap(__builtin_bit_cast(unsigned, v), __builtin_bit_cast(unsigned, v2), false, false); const unsigned a_ = rr[0], b_ = rr[1]; return __uint_as_float(a_) + __uint_as_float(b_); }
__device__ __forceinline__ float wave_sum_dpp(float v) {
    v += dppf<0xB1>(v); v += dppf<0x4E>(v); v += dppf<0x141>(v); v += dppf<0x140>(v);
    return sum_x32(sum_x16(v));
}
#define LDS_WAIT() asm volatile("s_waitcnt lgkmcnt(0)" ::: "memory")

namespace pg8 {
struct EpiScaleBf16 {
    static constexpr bool PERM = true, AFTER_DRAIN = false;
    bf16_t* O; int ldc; const float* rs;
    __device__ __forceinline__ void operator()(const f32x4 (&acc)[2][2][4][2], const Unit& u, int wr, int wc, int fr, int fq) const {
        const int row0 = u.pm * BM + wr * 64 + fr, col0 = u.pn * BM + wc * 32 + 8 * fq;
        float sc[2][4];
#pragma unroll
        for (int ai = 0; ai < 2; ++ai)
#pragma unroll
            for (int m = 0; m < 4; ++m) sc[ai][m] = rs[row0 + ai * HALF + m * 16];
#pragma unroll
        for (int ai = 0; ai < 2; ++ai)
#pragma unroll
            for (int m = 0; m < 4; ++m) { const int row = row0 + ai * HALF + m * 16; const float s = sc[ai][m]; bf16_t* rowp = O + (size_t)row * ldc + col0;
#pragma unroll
                for (int bj = 0; bj < 2; ++bj) { const f32x4 v0 = acc[ai][bj][m][0] * s, v1 = acc[ai][bj][m][1] * s;
                    u32x4 w; w.x = cvt_pk_bf16(v0[0], v0[1]); w.y = cvt_pk_bf16(v0[2], v0[3]); w.z = cvt_pk_bf16(v1[0], v1[1]); w.w = cvt_pk_bf16(v1[2], v1[3]);
                    *(u32x4*)(rowp + bj * HALF) = w; } }
    }
};
struct EpiResidX {
    static constexpr bool PERM = true, AFTER_DRAIN = false;
    const float* srcA; const float* srcB;
    bf16_t* xb; float* ss; const PG8_LAS float* tab;
    __device__ __forceinline__ void kscale(f32x4 (&acc)[2][2][4][2], int ui, int which, int wr, int fr) const {
#pragma unroll
        for (int ai = 0; ai < 2; ++ai)
#pragma unroll
            for (int m = 0; m < 4; ++m) { const float f = tab[(ui * 256 + ai * HALF + wr * 64 + m * 16 + fr) * 4 + which];
#pragma unroll
                for (int bj = 0; bj < 2; ++bj)
#pragma unroll
                    for (int n = 0; n < 2; ++n) acc[ai][bj][m][n] = acc[ai][bj][m][n] * f; }
    }
    __device__ __forceinline__ void final(const f32x4 (&acc)[2][2][4][2], const Unit& u, int ui, int wr, int wc, int fr, int fq) const {
        const int row0 = u.pm * BM + wr * 64 + fr, col0 = u.pn * BM + wc * 32 + 8 * fq;
#pragma unroll
        for (int ai = 0; ai < 2; ++ai) {
            f32x4 xr[4][2][2];
#pragma unroll
            for (int m = 0; m < 4; ++m) { const int row = row0 + ai * HALF + m * 16;
                const float* src = (row < 16384 ? srcA + (size_t)row * 2048 : srcB + (size_t)(row - 16384) * 2048) + col0;
#pragma unroll
                for (int bj = 0; bj < 2; ++bj) { xr[m][bj][0] = *(const f32x4*)(src + bj * HALF); xr[m][bj][1] = *(const f32x4*)(src + bj * HALF + 4); } }
#pragma unroll
            for (int m = 0; m < 4; ++m) { const int row = row0 + ai * HALF + m * 16; const float f = tab[(ui * 256 + ai * HALF + wr * 64 + m * 16 + fr) * 4 + 2]; float s = 0.f;
#pragma unroll
                for (int bj = 0; bj < 2; ++bj) { const f32x4 v0 = acc[ai][bj][m][0] * f + xr[m][bj][0], v1 = acc[ai][bj][m][1] * f + xr[m][bj][1];
                    s += (v0[0] * v0[0] + v0[1] * v0[1]) + (v0[2] * v0[2] + v0[3] * v0[3]) + (v1[0] * v1[0] + v1[1] * v1[1]) + (v1[2] * v1[2] + v1[3] * v1[3]);
                    u32x4 w; w.x = cvt_pk_bf16(v0[0], v0[1]); w.y = cvt_pk_bf16(v0[2], v0[3]); w.z = cvt_pk_bf16(v1[0], v1[1]); w.w = cvt_pk_bf16(v1[2], v1[3]);
                    *(u32x4*)(xb + (size_t)row * 2048 + col0 + bj * HALF) = w; }
                s = sum_x32(sum_x16(s)); asm volatile("" : "+v"(s));
                if (fq == 0) atomicAdd(ss + row, s); }
        }
    }
    __device__ __forceinline__ void operator()(const f32x4 (&acc)[2][2][4][2], const Unit& u, int wr, int wc, int fr, int fq) const {}
};
struct EpiResidB {
    static constexpr bool PERM = true, AFTER_DRAIN = false;
    bf16_t* xb; float* ss; int row_base;
    __device__ __forceinline__ void operator()(const f32x4 (&acc)[2][2][4][2], const Unit& u, int wr, int wc, int fr, int fq) const {
        const int row0 = row_base + u.pm * BM + wr * 64 + fr, col0 = u.pn * BM + wc * 32 + 8 * fq;
#pragma unroll
        for (int ai = 0; ai < 2; ++ai) {
            u32x4 xr[4][2];
#pragma unroll
            for (int m = 0; m < 4; ++m) { const bf16_t* rp = xb + (size_t)(row0 + ai * HALF + m * 16) * 2048 + col0;
#pragma unroll
                for (int bj = 0; bj < 2; ++bj) xr[m][bj] = *(const u32x4*)(rp + bj * HALF); }
#pragma unroll
            for (int m = 0; m < 4; ++m) { const int row = row0 + ai * HALF + m * 16; bf16_t* rp = xb + (size_t)row * 2048 + col0; float s = 0.f;
#pragma unroll
                for (int bj = 0; bj < 2; ++bj) { const u32x4 x = xr[m][bj]; float v[8];
#pragma unroll
                    for (int e = 0; e < 4; ++e) { v[2 * e] = __builtin_bit_cast(float, x[e] << 16) + acc[ai][bj][m][e >> 1][(2 * e) & 3]; v[2 * e + 1] = __builtin_bit_cast(float, x[e] & 0xffff0000u) + acc[ai][bj][m][e >> 1][(2 * e + 1) & 3]; }
#pragma unroll
                    for (int e = 0; e < 8; ++e) s += v[e] * v[e];
                    u32x4 w; w.x = cvt_pk_bf16(v[0], v[1]); w.y = cvt_pk_bf16(v[2], v[3]); w.z = cvt_pk_bf16(v[4], v[5]); w.w = cvt_pk_bf16(v[6], v[7]);
                    *(u32x4*)(rp + bj * HALF) = w; }
                s = sum_x32(sum_x16(s)); asm volatile("" : "+v"(s));
                if (fq == 0) atomicAdd(ss + row, s); }
        }
    }
};
struct EpiSwiglu {
    static constexpr bool PERM = true, AFTER_DRAIN = false;
    bf16_t* act; const float* ss; int row_base;
    __device__ __forceinline__ void operator()(const f32x4 (&acc)[2][2][4][2], const Unit& u, int wr, int wc, int fr, int fq) const {
        const int row0 = u.pm * BM + wr * 64 + fr, col0 = u.pn * HALF + wc * 32 + 8 * fq;
        float sq[2][4];
#pragma unroll
        for (int ai = 0; ai < 2; ++ai)
#pragma unroll
            for (int m = 0; m < 4; ++m) sq[ai][m] = ss[row_base + row0 + ai * HALF + m * 16];
#pragma unroll
        for (int ai = 0; ai < 2; ++ai)
#pragma unroll
            for (int m = 0; m < 4; ++m) { const int row = row0 + ai * HALF + m * 16; const float rs = __builtin_amdgcn_rsqf(sq[ai][m] * (1.0f / 2048.0f) + 1e-6f);
                float a[8];
#pragma unroll
                for (int n = 0; n < 2; ++n)
#pragma unroll
                    for (int j = 0; j < 4; ++j) { const float g = acc[ai][0][m][n][j] * rs, uu = acc[ai][1][m][n][j] * rs;
                        a[n * 4 + j] = g * uu * __builtin_amdgcn_rcpf(1.0f + __builtin_amdgcn_exp2f(-1.4426950408889634f * g)); }
                u32x4 w; w.x = cvt_pk_bf16(a[0], a[1]); w.y = cvt_pk_bf16(a[2], a[3]); w.z = cvt_pk_bf16(a[4], a[5]); w.w = cvt_pk_bf16(a[6], a[7]);
                *(u32x4*)(act + (size_t)row * 5632 + col0) = w; }
    }
};
}

struct TItem { const float* W; const float* gain; bf16_t* WT; int K, N, k0, n0, drow0; };
__device__ __forceinline__ void titem_load(const TItem& t, float (&r)[32], int lane) {
    const float* p = t.W + (size_t)(t.k0 + (lane >> 5)) * t.N + t.n0 + (lane & 31);
#pragma unroll
    for (int i = 0; i < 32; ++i) r[i] = p[(size_t)(2 * i) * t.N];
}
__device__ __forceinline__ void titem_store(const TItem& t, const float (&r)[32], LAS float* scr, int lane) {
#pragma unroll
    for (int i = 0; i < 32; ++i) scr[(2 * i + (lane >> 5)) * 33 + (lane & 31)] = r[i];
    LDS_WAIT(); asm volatile("" ::: "memory");
    const int c = lane & 7;
    f32x4 g0 = {1.f, 1.f, 1.f, 1.f}, g1 = g0;
    if (t.gain) { g0 = *(const f32x4*)(t.gain + t.k0 + 8 * c); g1 = *(const f32x4*)(t.gain + t.k0 + 8 * c + 4); }
#pragma unroll
    for (int j = 0; j < 4; ++j) { const int n = (lane >> 3) + 8 * j; const LAS float* s = scr + (8 * c) * 33 + n;
        v4u o; o.x = pk2(s[0 * 33] * g0.x, s[1 * 33] * g0.y); o.y = pk2(s[2 * 33] * g0.z, s[3 * 33] * g0.w); o.z = pk2(s[4 * 33] * g1.x, s[5 * 33] * g1.y); o.w = pk2(s[6 * 33] * g1.z, s[7 * 33] * g1.w);
        *(v4u*)(t.WT + (size_t)(t.drow0 + n) * t.K + t.k0 + 8 * c) = o; }
    LDS_WAIT(); asm volatile("" ::: "memory");
}
__device__ __forceinline__ void rows4_to_bf16(const float* __restrict__ x0, bf16_t* __restrict__ o0, float* __restrict__ rstd_out, int lane) {
    f32x4 v[4][8];
#pragma unroll
    for (int r = 0; r < 4; ++r)
#pragma unroll
        for (int j = 0; j < 8; ++j) v[r][j] = ((const f32x4*)(x0 + (size_t)r * 2048) + lane)[64 * j];
#pragma unroll
    for (int r = 0; r < 4; ++r) { float s = 0.f;
#pragma unroll
        for (int j = 0; j < 8; ++j) s += (v[r][j].x * v[r][j].x + v[r][j].y * v[r][j].y) + (v[r][j].z * v[r][j].z + v[r][j].w * v[r][j].w);
        s = wave_sum(s);
        if (lane == 0) rstd_out[r] = 1.0f / sqrtf(s * (1.0f / 2048.0f) + EPS);
        v2u* o8 = (v2u*)(o0 + (size_t)r * 2048) + lane;
#pragma unroll
        for (int j = 0; j < 8; ++j) { v2u w; w.x = pk2(v[r][j].x, v[r][j].y); w.y = pk2(v[r][j].z, v[r][j].w); o8[64 * j] = w; } }
}
__device__ __forceinline__ void sincos_ang(float ang, float& s, float& c) {
    double t = (double)ang * 0.15915494309189535; t -= __builtin_floor(t); const float f = (float)t;
    s = __builtin_amdgcn_sinf(f); c = __builtin_amdgcn_cosf(f);
}

#ifndef ATT_MASK
#define ATT_MASK 7
#endif
struct Params { const float* in[17]; float* out; unsigned char* ws; int ph_lo, ph_hi; };

__global__ void __launch_bounds__(NWAVES * 64, 2) hymba_fwd(Params P) {
    __builtin_assume(__builtin_amdgcn_workitem_id_y() == 0); __builtin_assume(__builtin_amdgcn_workitem_id_z() == 0);
    extern __shared__ __attribute__((aligned(16))) unsigned char lds[];
    cg::grid_group grid = cg::this_grid();
    const int tid = threadIdx.x, lane = tid & 63, wave = __builtin_amdgcn_readfirstlane(tid >> 6);
    const int G = gridDim.x, cu = blockIdx.x;
    const int gw = cu * NWAVES + wave, NGW = G * NWAVES;
    unsigned char* ws = P.ws;
    float* rstd1 = (float*)(ws + WS_RSTD1); float* ss2 = (float*)(ws + WS_SS2); float* ss3 = (float*)(ws + WS_SS3); float* rstdm = (float*)(ws + WS_RSTDM);
    bf16_t* WinT = (bf16_t*)(ws + WS_WIN); bf16_t* WmemT = (bf16_t*)(ws + WS_WMEM); bf16_t* WoutT = (bf16_t*)(ws + WS_WOUT); bf16_t* WguT = (bf16_t*)(ws + WS_WGU); bf16_t* WdT = (bf16_t*)(ws + WS_WD);
    bf16_t* kvm = (bf16_t*)(ws + WS_KVM); bf16_t* memb = (bf16_t*)(ws + WS_MEMB);
    bf16_t* xb = (bf16_t*)(ws + WS_XB); bf16_t* Obuf = xb; bf16_t* act = xb;
    float* hs = (float*)(ws + WS_HS);
    bf16_t* proj = (bf16_t*)(ws + WS_PROJ); bf16_t* x1b = (bf16_t*)(ws + WS_X1B);
    const float* x_prompt = P.in[0]; const float* x_sample = P.in[1];
    const int lo = P.ph_lo, hi_ = P.ph_hi;
#ifndef PH_MASK
#define PH_MASK 0x7ff
#endif
#define IN(k) (((PH_MASK >> (k)) & 1) && lo <= (k) && (k) < hi_)
#define SEAM(k) do { if (IN(k) && IN((k) + 1)) grid.sync(); } while (0)

#ifdef PROBE_SYNCS
    for (int i_ = 0; i_ < PROBE_SYNCS; ++i_) grid.sync();
#endif
    if (IN(0)) {
        for (int i = cu * 512 + tid; i < MTOK; i += G * 512) { ss2[i] = 0.f; ss3[i] = 0.f; }
        LAS float* scr = (LAS float*)((LAS unsigned char*)lds + wave * 16384);
        constexpr int I_IN = 32 * 96, I_MEM = 32 * 32, I_OUT = 32 * 64, I_GU = 32 * 352, I_D = 88 * 64;
        constexpr int NITEMS = I_IN + I_MEM + I_OUT + I_GU + I_D;
        auto decode = [&](int it) -> TItem {
            int r = it; TItem t;
            if (r < I_IN) { const int kb = r / 96, nb = r % 96; t = TItem{P.in[6], P.in[4], WinT, 2048, INW, 64 * kb, 32 * nb, 32 * nb}; return t; } r -= I_IN;
            if (r < I_MEM) { const int kb = r / 32, nb = r % 32; t = TItem{P.in[7], P.in[5], WmemT, 2048, MKV, 64 * kb, 32 * nb, 32 * nb}; return t; } r -= I_MEM;
            if (r < I_OUT) { const int kb = r / 64, nb = r % 64; t = TItem{P.in[12], P.in[11], WoutT, 2048, DM, 64 * kb, 32 * nb, 32 * nb}; return t; } r -= I_OUT;
            if (r < I_GU) { const int kb = r / 352, nb = r % 352; const int n0 = 32 * nb; const int nn = n0 < DFF ? n0 : n0 - DFF;
                const int drow = (nn >> 7) * 256 + (n0 < DFF ? 0 : 128) + (nn & 127);
                t = TItem{P.in[14], P.in[13], WguT, 2048, NGU, 64 * kb, n0, drow}; return t; } r -= I_GU;
            { const int kb = r / 64, nb = r % 64; t = TItem{P.in[15], nullptr, WdT, DFF, DM, 64 * kb, 32 * nb, 32 * nb}; return t; }
        };
        {
            float ra[32], rb[32]; int it = gw;
            TItem ta, tb;
            if (it < NITEMS) { ta = decode(it); titem_load(ta, ra, lane); }
            while (it < NITEMS) {
                const int itb = it + NGW; if (itb < NITEMS) { tb = decode(itb); titem_load(tb, rb, lane); }
                titem_store(ta, ra, scr, lane);
                if (itb >= NITEMS) break;
                const int ita = itb + NGW; if (ita < NITEMS) { ta = decode(ita); titem_load(ta, ra, lane); }
                titem_store(tb, rb, scr, lane);
                it = ita;
            }
        }
        for (int m = gw * 4; m < MTOK; m += NGW * 4) rows4_to_bf16(m < SEQ0 ? x_prompt + (size_t)m * DM : x_sample + (size_t)(m - SEQ0) * DM, xb + (size_t)m * DM, rstd1 + m, lane);
        for (int m = gw * 4; m < MEMR; m += NGW * 4) rows4_to_bf16(m < 256 ? P.in[2] + (size_t)m * DM : P.in[3] + (size_t)(m - 256) * DM, memb + (size_t)m * DM, rstdm + m, lane);
    }
    SEAM(0);

    if (IN(1)) {
        { pg8::Gemm g{xb, WinT, MTOK, INW, DM}; pg8::StaticOrder S; S.init(MTOK, INW, G, cu);
          pg8::EpiScaleBf16 E{proj, INW, rstd1};
          pg8::gemm_phase<pg8::EpiScaleBf16, pg8::StaticOrder, true, true>((LAS unsigned char*)lds, g, S, E); }
    }
    SEAM(1);

    if (IN(2)) {
        int tidf_ = threadIdx.x; asm volatile("" : "+v"(tidf_)); const int lane = tidf_ & 63, wave = __builtin_amdgcn_readfirstlane(tidf_ >> 6), gw = cu * NWAVES + wave; (void)lane; (void)gw;
        for (int task = wave * G + cu; task < 768; task += NWAVES * G) {
            const int mt = task >> 4, nt = task & 15, fr = lane & 15, fq = lane >> 4;
            const bf16_t* ap = memb + (size_t)(mt * 16 + fr) * DM + fq * 8;
            const bf16_t* bp = WmemT + (size_t)(nt * 64 + fr) * DM + fq * 8;
            f32x4 acc[4] = {};
#pragma unroll 4
            for (int k0 = 0; k0 < DM; k0 += 32) {
                const pg8::bf16x8 a = *(const pg8::bf16x8*)(ap + k0);
#pragma unroll
                for (int j = 0; j < 4; ++j) { const pg8::bf16x8 b = *(const pg8::bf16x8*)(bp + (size_t)j * 16 * DM + k0);
                    acc[j] = __builtin_amdgcn_mfma_f32_16x16x32_bf16(a, b, acc[j], 0, 0, 0); }
            }
#pragma unroll
            for (int i = 0; i < 4; ++i) { const int row = mt * 16 + fq * 4 + i; const float rs = rstdm[row];
#pragma unroll
                for (int j = 0; j < 4; ++j) kvm[(size_t)row * MKV + nt * 64 + j * 16 + fr] = (bf16_t)f2bf(acc[j][i] * rs); }
        }
        const float L2T = 13.287712379549449f;
        const int l5 = lane & 31, l4 = lane & 15;
        const float invA0 = exp2f(-(float)(2 * l5) * (L2T / 64.0f)), invA1 = exp2f(-(float)(2 * l5 + 1) * (L2T / 64.0f));
        const float invB0 = exp2f(-(float)(2 * l4) * (L2T / 32.0f)), invB1 = exp2f(-(float)(2 * l4 + 1) * (L2T / 32.0f));
        const float sgnA = (lane & 32) ? 1.f : -1.f, sgnB = (lane & 16) ? 1.f : -1.f;
        const float kg0 = P.in[10][2 * lane], kg1 = P.in[10][2 * lane + 1];
        for (int row0 = gw * 4; row0 < MTOK; row0 += NGW * 4) {
            unsigned wq[4][4];
#pragma unroll
            for (int r = 0; r < 4; ++r) { const unsigned* prow = (const unsigned*)(proj + (size_t)(row0 + r) * INW);
#pragma unroll
                for (int h = 0; h < 2; ++h) { wq[r][h] = prow[512 + h * 64 + lane]; wq[r][2 + h] = prow[1024 + h * 64 + lane]; } }
#pragma unroll
            for (int r = 0; r < 4; ++r) { const int row = row0 + r;
                const int t = row < SEQ0 ? row : ((row - SEQ0) & (SEQS - 1));
                unsigned* prow = (unsigned*)(proj + (size_t)row * INW);
                float sa0, ca0, sa1, ca1; sincos_ang((float)t * invA0, sa0, ca0); sincos_ang((float)t * invA1, sa1, ca1);
                sa0 *= sgnA; sa1 *= sgnA;
#pragma unroll
                for (int h = 0; h < 2; ++h) { const unsigned w = wq[r][h]; const unsigned pw = (unsigned)__shfl_xor((int)w, 32);
                    const float y0 = bflo(w) * ca0 + bflo(pw) * sa0, y1 = bfhi(w) * ca1 + bfhi(pw) * sa1;
                    prow[512 + h * 64 + lane] = pk2(y0, y1); }
                const float posB = (float)((lane & 32) ? (t & 63) : (t >> 6));
                float sb0, cb0, sb1, cb1; sincos_ang(posB * invB0, sb0, cb0); sincos_ang(posB * invB1, sb1, cb1);
                sb0 *= sgnB; sb1 *= sgnB;
#pragma unroll
                for (int h = 0; h < 2; ++h) { const unsigned w = wq[r][2 + h]; float x0 = bflo(w), x1 = bfhi(w);
                    const float ssq = wave_sum(x0 * x0 + x1 * x1); const float rr = 1.0f / sqrtf(ssq * (1.0f / 128.0f) + EPS);
                    x0 *= rr * kg0; x1 *= rr * kg1;
                    const float p0 = __shfl_xor(x0, 16), p1 = __shfl_xor(x1, 16);
                    prow[1024 + h * 64 + lane] = pk2(x0 * cb0 + p0 * sb0, x1 * cb1 + p1 * sb1); }
            }
        }
    }
    SEAM(2);

    if (IN(3)) {
        const att::bf16* pj = (const att::bf16*)proj; const att::bf16* kv = (const att::bf16*)kvm;
        if (ATT_MASK & 1) for (int ub = cu; ub < 512; ub += G) {
            const int v = ub & 255, xcd = v & 7, idx = v >> 3; int head, row0, srow, slen;
            if (ub < 256) { head = xcd >> 1; row0 = ((xcd & 1) * 32 + idx) * 256; srow = 0; slen = SEQ0; }
            else { const int b = xcd >> 2; head = xcd & 3; srow = SEQ0 + b * SEQS; slen = SEQS; row0 = srow + idx * 256; }
            const int kvh = head >> 1;
            att::attn_body<0, 2>(pj + (size_t)row0 * INW + 1536 + head * 128, pj + (size_t)srow * INW + 2048 + kvh * 128, pj + (size_t)srow * INW + 2304 + kvh * 128,
                                 Obuf + (size_t)row0 * DM + 1024 + head * 128, hs + (size_t)row0 * 16 + 8 + head, slen, INW, 0, nullptr, row0 - srow, P.in[9], (char*)lds);
        }
        if (ATT_MASK & 2) for (int ua = cu; ua < 1024; ua += G) {
            const int hp = ua & 3, row0 = (ua >> 2) * 128, h0 = hp * 2, kvh = hp >> 1;
            const int srow = row0 < SEQ0 ? 0 : SEQ0 + ((row0 - SEQ0) / SEQS) * SEQS, send = row0 < SEQ0 ? SEQ0 : srow + SEQS;
            const int ks = max(row0 - 128, srow), ke = min(row0 + 256, send);
            att::attn_body<1, 1>(pj + (size_t)row0 * INW + h0 * 128, pj + (size_t)ks * INW + 1024 + kvh * 128, pj + (size_t)ks * INW + 1280 + kvh * 128,
                                 Obuf + (size_t)row0 * DM + h0 * 128, hs + (size_t)row0 * 16 + h0, ke - ks, INW, row0 - ks, P.in[8] + h0, row0 - srow, nullptr, (char*)lds);
        }
        if (ATT_MASK & 4) for (int um = cu; um < 512; um += G) {
            const int head = um & 3, qb = um >> 2, row0 = qb * 256; const int sq = row0 < SEQ0 ? 0 : 1 + (row0 - SEQ0) / SEQS;
            att::attn_body<0, 0>(pj + (size_t)row0 * INW + 2560 + head * 128, kv + (size_t)sq * 256 * MKV + head * 128, kv + (size_t)sq * 256 * MKV + 512 + head * 128,
                                 Obuf + (size_t)row0 * DM + 1536 + head * 128, hs + (size_t)row0 * 16 + 12 + head, 256, MKV, 0, nullptr, 0, nullptr, (char*)lds);
        }
    }
    SEAM(3);

    SEAM(4);

    if (IN(5)) {
        pg8::Gemm g{Obuf, WoutT, MTOK, DM, DM}; pg8::StaticOrder S; S.init(MTOK, DM, G, cu);
        LAS float* tab = (LAS float*)((LAS unsigned char*)lds + 131072);
        {
            pg8::Unit u;
            for (int ui = 0; ui < 4 && S.next(ui, u); ++ui) if (tid < 256) {
                const f32x4* hp = (const f32x4*)(hs + (size_t)(u.pm * 256 + tid) * 16);
                const f32x4 a0 = hp[0], a1 = hp[1], b0 = hp[2], m0 = hp[3];
                const float sA = ((a0[0] + a0[1]) + (a0[2] + a0[3])) + ((a1[0] + a1[1]) + (a1[2] + a1[3])), sB = (b0[0] + b0[1]) + (b0[2] + b0[3]), sM = (m0[0] + m0[1]) + (m0[2] + m0[3]);
                const float rA = 1.0f / sqrtf(sA * (1.0f / 1024.0f) + EPS), rB = 1.0f / sqrtf(sB * (1.0f / 512.0f) + EPS), rM = 1.0f / sqrtf(sM * (1.0f / 512.0f) + EPS);
                f32x4 t4; t4[0] = rA / rB; t4[1] = rB / rM; t4[2] = rM; t4[3] = 0.f;
                *(LAS f32x4*)(tab + (ui * 256 + tid) * 4) = t4;
            }
            __syncthreads();
        }
        pg8::EpiResidX E{x_prompt, x_sample, x1b, ss2, (const LAS float*)tab};
        pg8::gemm_phase<pg8::EpiResidX, pg8::StaticOrder, true, true, true>((LAS unsigned char*)lds, g, S, E);
    }
    SEAM(5);

#pragma unroll
    for (int half = 0; half < 2; ++half) {
        const int rb = half * 16384;
        if (IN(6 + 2 * half)) {
            pg8::Gemm g{x1b + (size_t)rb * DM, WguT, 16384, NGU, DM}; pg8::StaticOrder S; S.init(16384, NGU, G, cu);
            pg8::EpiSwiglu E{act, ss2, rb};
            pg8::gemm_phase<pg8::EpiSwiglu, pg8::StaticOrder, true, true>((LAS unsigned char*)lds, g, S, E);
        }
        SEAM(6 + 2 * half);
        if (IN(7 + 2 * half)) {
            pg8::Gemm g{act, WdT, 16384, DM, DFF}; pg8::StaticOrder S; S.init(16384, DM, G, cu);
            pg8::EpiResidB E{x1b, ss3, rb};
            pg8::gemm_phase<pg8::EpiResidB, pg8::StaticOrder, true, true>((LAS unsigned char*)lds, g, S, E);
        }
        SEAM(7 + 2 * half);
    }

    if (IN(10)) {
        int tidf_ = threadIdx.x; asm volatile("" : "+v"(tidf_)); const int lane = tidf_ & 63, wave = __builtin_amdgcn_readfirstlane(tidf_ >> 6), gw = cu * NWAVES + wave; (void)lane; (void)gw;
        const f32x4* gf = (const f32x4*)P.in[16] + lane; f32x4 gv[8];
#pragma unroll
        for (int j = 0; j < 8; ++j) gv[j] = gf[64 * j];
        for (int row0 = gw * 4; row0 < MTOK; row0 += NGW * 4) {
            v2u y[4][8]; float rs[4];
#pragma unroll
            for (int r = 0; r < 4; ++r) { rs[r] = ss3[row0 + r];
#pragma unroll
                for (int j = 0; j < 8; ++j) y[r][j] = ((const v2u*)(x1b + (size_t)(row0 + r) * DM) + lane)[64 * j]; }
#pragma unroll
            for (int r = 0; r < 4; ++r) { const float q = 1.0f / sqrtf(rs[r] * (1.0f / 2048.0f) + EPS);
                f32x4* op = (f32x4*)(P.out + (size_t)(row0 + r) * DM) + lane;
#pragma unroll
                for (int j = 0; j < 8; ++j) { f32x4 v; v.x = bflo(y[r][j].x); v.y = bfhi(y[r][j].x); v.z = bflo(y[r][j].y); v.w = bfhi(y[r][j].y); op[64 * j] = v * q * gv[j]; } }
        }
    }
#undef IN
#undef SEAM
}

constexpr int NPH = 11;
#ifndef N_SPLIT
#define N_SPLIT 0
#endif
extern "C" void kernel_launch(void* const* d_in, const int* in_sizes, int n_in, void* d_out, int out_size, void* d_ws, size_t ws_size, hipStream_t stream) {
    static int grid = 0;
    if (grid == 0) {
        if (n_in != 17 || out_size != MTOK * DM || ws_size < WS_END) { fprintf(stderr, "kernel_launch: unexpected shapes n_in %d out %d ws %zu\n", n_in, out_size, ws_size); grid = -1; return; }
        int dev = 0, cus = 0, per_cu = 0;
        (void)hipGetDevice(&dev); (void)hipDeviceGetAttribute(&cus, hipDeviceAttributeMultiprocessorCount, dev);
        if (hipFuncSetAttribute((const void*)hymba_fwd, hipFuncAttributeMaxDynamicSharedMemorySize, LDS_BYTES) != hipSuccess) { fprintf(stderr, "kernel_launch: hipFuncSetAttribute failed\n"); grid = -1; return; }
        (void)hipOccupancyMaxActiveBlocksPerMultiprocessor(&per_cu, (const void*)hymba_fwd, NWAVES * 64, LDS_BYTES);
        if (per_cu < 1) { fprintf(stderr, "kernel_launch: occupancy query says %d blocks per CU\n", per_cu); per_cu = 1; }
        (void)hipGetLastError();
        grid = cus;
    }
    if (grid < 0) return;
    Params p{};
    for (int i = 0; i < 17; ++i) p.in[i] = (const float*)d_in[i];
    p.out = (float*)d_out; p.ws = (unsigned char*)d_ws;
#if N_SPLIT
    for (int k = 0; k < NPH; ++k) { p.ph_lo = k; p.ph_hi = k + 1; hipLaunchKernelGGL(hymba_fwd, dim3(grid), dim3(NWAVES * 64), LDS_BYTES, stream, p); }
#else
    void* args[] = {&p};
#ifdef PROBE_REPEAT
    p.ph_lo = 0; p.ph_hi = PROBE_REPEAT + 1;
    (void)hipLaunchCooperativeKernel((const void*)hymba_fwd, dim3(grid), dim3(NWAVES * 64), args, LDS_BYTES, stream);
    p.ph_lo = PROBE_REPEAT; p.ph_hi = NPH;
    (void)hipLaunchCooperativeKernel((const void*)hymba_fwd, dim3(grid), dim3(NWAVES * 64), args, LDS_BYTES, stream);
#else
    p.ph_lo = 0; p.ph_hi = NPH;
    hipError_t e = hipLaunchCooperativeKernel((const void*)hymba_fwd, dim3(grid), dim3(NWAVES * 64), args, LDS_BYTES, stream);
    if (e != hipSuccess) fprintf(stderr, "cooperative launch failed: %s (grid %d)\n", hipGetErrorString(e), grid);
#endif
#endif
}
```

```cpp
#include <hip/hip_runtime.h>
#include <hip/hip_cooperative_groups.h>
#include <hip/hip_bf16.h>
#include <cstdio>
#include <cstdint>
#include <cmath>
namespace cg = cooperative_groups;
namespace pg8 {
#define PG8_LAS __attribute__((address_space(3)))
typedef unsigned short bf16_t;
typedef short bf16x8 __attribute__((ext_vector_type(8)));
typedef float f32x4 __attribute__((ext_vector_type(4)));
typedef unsigned u32x4 __attribute__((ext_vector_type(4)));
constexpr int BM = 256, BK = 64, HALF = 128, HTB = HALF * BK * 2  , STAGE_BYTES = 8 * HTB, NXCD = 8, WGM = 8;

__host__ __device__ __forceinline__ int lds_byte(int r, int c) { const int st = (r >> 4) * 2 + (c >> 5), rr = r & 15, cc = c & 31, ob = rr * 64 + cc * 2; return st * 1024 + (ob ^ (((ob >> 9) & 1) << 5)); }
__host__ __device__ __forceinline__ void stage_rc(int b, int& R, int& C) { const int st = b / 1024, sb = b % 1024, swz = sb ^ (((sb >> 9) & 1) << 5); R = (st >> 1) * 16 + swz / 64; C = (st & 1) * 32 + (swz % 64) / 2; }
__host__ __device__ __forceinline__ int perm32(int rho) { const int n = rho >> 4, i = rho & 15; return 8 * (i >> 2) + 4 * n + (i & 3); }

struct Unit { int pm, pn; };
struct Gemm { const bf16_t* A; const bf16_t* Bt; int M, N, K; };

struct StaticOrder {
    int nM, nN, nwg, G, c;
    __host__ __device__ void init(int M, int N, int G_, int c_) { nM = M / BM; nN = N / BM; nwg = nM * nN; G = G_; c = c_; }
    __host__ __device__ bool next(int i, Unit& u) const {
        const long L = (long)i * G + c; if (L >= nwg) return false;
        int wgid = (int)L; { const int q = nwg / NXCD, r = nwg % NXCD, xcd = wgid % NXCD, off = wgid / NXCD; wgid = (xcd < r ? xcd * (q + 1) : r * (q + 1) + (xcd - r) * q) + off; }
        const int nig = WGM * nN, gid = wgid / nig, fm = gid * WGM, gsz = (nM - fm) < WGM ? (nM - fm) : WGM;
        u.pm = fm + ((wgid % nig) % gsz); u.pn = (wgid % nig) / gsz; return true;
    }
    __device__ __forceinline__ void a_ready(const Unit&) const {}
    __device__ __forceinline__ void done(const Unit&) const {}
};

__device__ __forceinline__ unsigned cvt_pk_bf16(float lo, float hi) { unsigned r; asm volatile("v_cvt_pk_bf16_f32 %0, %1, %2" : "=v"(r) : "v"(lo), "v"(hi)); return r; }
typedef float f32x2 __attribute__((ext_vector_type(2)));
template <class Epi, class Sched, bool ALIGN_EPI = false, bool SP2 = false, bool KSEG = false>
__device__ __forceinline__ void gemm_phase(PG8_LAS unsigned char* lds, const Gemm g, const Sched& S, const Epi& E) {
    const int tid = threadIdx.x, wid = __builtin_amdgcn_readfirstlane(tid >> 6), lane = tid & 63, wr = wid >> 2, wc = wid & 3, fr = lane & 15, fq = lane >> 4;
    const int K = g.K, nt = K / BK;
    unsigned voffA[2], voffB[2];
#pragma unroll
    for (int i = 0; i < 2; ++i) { int R, C; stage_rc(tid * 16 + i * 8192, R, C); const int Rb = Epi::PERM ? ((R & ~31) + perm32(R & 31)) : R;
        voffA[i] = (unsigned)(R * K + C) * 2u; voffB[i] = (unsigned)(Rb * K + C) * 2u; }
    const size_t kstep = (size_t)(BK * 2);
    const size_t hstep = (size_t)HALF * K * 2;
    const size_t tstep = 2 * hstep;
    const unsigned ldsw = (unsigned)wid * 1024u;
    const int aoff = lds_byte(wr * 64 + fr, fq * 8), boff = lds_byte(wc * 32 + fr, fq * 8);
#define PG8_SA(b, h) (((b) * 2 + (h)) * HTB)
#define PG8_SB(b, h) ((4 + (b) * 2 + (h)) * HTB)
#define PG8_STAGE(bufoff, gbase, voff) do { _Pragma("unroll") for (int _i = 0; _i < 2; ++_i) \
        __builtin_amdgcn_global_load_lds((const unsigned*)((const char*)(gbase) + (voff)[_i]), (PG8_LAS unsigned*)(lds + (bufoff) + ldsw + _i * 8192), 16, 0, 0); } while (0)
#define PG8_LDA(dst, b, h) do { _Pragma("unroll") for (int m = 0; m < 4; ++m) _Pragma("unroll") for (int k = 0; k < 2; ++k) dst[m][k] = *(const PG8_LAS bf16x8*)(lds + PG8_SA(b, h) + aoff + m * 2048 + k * 1024); } while (0)
#define PG8_LDB(dst, b, h) do { _Pragma("unroll") for (int n = 0; n < 2; ++n) _Pragma("unroll") for (int k = 0; k < 2; ++k) dst[n][k] = *(const PG8_LAS bf16x8*)(lds + PG8_SB(b, h) + boff + n * 2048 + k * 1024); } while (0)
#define PG8_MMA(ai, bj, At, Bt) do { __builtin_amdgcn_s_setprio(1); _Pragma("unroll") for (int m = 0; m < 4; ++m) _Pragma("unroll") for (int n = 0; n < 2; ++n) _Pragma("unroll") for (int k = 0; k < 2; ++k) \
        acc[ai][bj][m][n] = __builtin_amdgcn_mfma_f32_16x16x32_bf16(Bt[n][k], At[m][k], acc[ai][bj][m][n], 0, 0, 0); __builtin_amdgcn_s_setprio(0); } while (0)
#define PG8_WAIT_V(n) asm volatile("s_waitcnt vmcnt(" #n ")" ::: "memory")
#define PG8_WAIT_L(n) asm volatile("s_waitcnt lgkmcnt(" #n ")" ::: "memory")
#define PG8_BAR __builtin_amdgcn_s_barrier()
#define PG8_SCHED __builtin_amdgcn_sched_barrier(0)
    Unit cur, nxt; int ui = 0;
    if (!S.next(0, cur)) return;
    f32x4 acc[2][2][4][2];
#pragma unroll
    for (int a = 0; a < 2; ++a)
#pragma unroll
        for (int b = 0; b < 2; ++b)
#pragma unroll
            for (int m = 0; m < 4; ++m)
#pragma unroll
                for (int n = 0; n < 2; ++n) acc[a][b][m][n] = (f32x4){0.f, 0.f, 0.f, 0.f};
    bf16x8 At[4][2], B0[2][2], B1[2][2];
    const char* cA = (const char*)g.A + (size_t)cur.pm * tstep; const char* cB = (const char*)g.Bt + (size_t)cur.pn * tstep;
    S.a_ready(cur);
    if constexpr (SP2) {
        PG8_STAGE(PG8_SB(0, 0), cB, voffB); PG8_STAGE(PG8_SB(0, 1), cB + hstep, voffB); PG8_STAGE(PG8_SA(0, 0), cA, voffA); PG8_STAGE(PG8_SA(0, 1), cA + hstep, voffA);
        if (wr == 1) PG8_BAR;
        PG8_WAIT_V(2); PG8_BAR;
        PG8_STAGE(PG8_SB(1, 0), cB + kstep, voffB); PG8_STAGE(PG8_SA(1, 0), cA + kstep, voffA); PG8_STAGE(PG8_SB(1, 1), cB + hstep + kstep, voffB);
        PG8_WAIT_V(6); PG8_BAR;
    } else {
        PG8_STAGE(PG8_SB(0, 0), cB, voffB); PG8_STAGE(PG8_SA(0, 0), cA, voffA); PG8_STAGE(PG8_SB(0, 1), cB + hstep, voffB); PG8_STAGE(PG8_SA(0, 1), cA + hstep, voffA);
        if (wr == 1) PG8_BAR;
        PG8_WAIT_V(4); PG8_BAR;
        PG8_STAGE(PG8_SB(1, 0), cB + kstep, voffB); PG8_STAGE(PG8_SA(1, 0), cA + kstep, voffA); PG8_STAGE(PG8_SB(1, 1), cB + hstep + kstep, voffB);
        PG8_WAIT_V(6); PG8_BAR;
    }
    for (;;) {
        const bool has_next = S.next(ui + 1, nxt);
        const char* nA = has_next ? (const char*)g.A + (size_t)nxt.pm * tstep : cA; const char* nB = has_next ? (const char*)g.Bt + (size_t)nxt.pn * tstep : cB;
        for (int t = 0; t < nt; t += 2) {
            const bool last = (t == nt - 2);
            const char* a1 = cA + (size_t)(t + 1) * kstep;
            const char* a2 = last ? nA : cA + (size_t)(t + 2) * kstep; const char* b2 = last ? nB : cB + (size_t)(t + 2) * kstep;
            const char* a3 = a2 + kstep; const char* b3 = b2 + kstep;
            if (last && has_next) S.a_ready(nxt);
            if constexpr (SP2) {
            PG8_LDB(B0, 0, 0); PG8_LDB(B1, 0, 1); PG8_SCHED; PG8_LDA(At, 0, 0); PG8_STAGE(PG8_SA(1, 1), a1 + hstep, voffA);
            PG8_WAIT_V(8); PG8_WAIT_L(0); PG8_BAR; PG8_MMA(0, 0, At, B0); PG8_MMA(0, 1, At, B1); PG8_BAR; PG8_SCHED;
            PG8_LDA(At, 0, 1); PG8_STAGE(PG8_SB(0, 0), b2, voffB); PG8_STAGE(PG8_SB(0, 1), b2 + hstep, voffB); PG8_STAGE(PG8_SA(0, 0), a2, voffA);
            PG8_WAIT_V(8); PG8_WAIT_L(0); PG8_BAR; PG8_MMA(1, 0, At, B0); PG8_MMA(1, 1, At, B1); PG8_BAR; PG8_SCHED;
            PG8_LDB(B0, 1, 0); PG8_LDB(B1, 1, 1); PG8_SCHED; PG8_LDA(At, 1, 0); PG8_STAGE(PG8_SA(0, 1), a2 + hstep, voffA);
            PG8_WAIT_V(8); PG8_WAIT_L(0); PG8_BAR; PG8_MMA(0, 0, At, B0); PG8_MMA(0, 1, At, B1); PG8_BAR; PG8_SCHED;
            PG8_LDA(At, 1, 1); PG8_STAGE(PG8_SB(1, 0), b3, voffB); PG8_STAGE(PG8_SB(1, 1), b3 + hstep, voffB); PG8_STAGE(PG8_SA(1, 0), a3, voffA);
            PG8_WAIT_V(8); PG8_WAIT_L(0); PG8_BAR; PG8_MMA(1, 0, At, B0); PG8_MMA(1, 1, At, B1); PG8_BAR; PG8_SCHED;
            } else {
            PG8_LDB(B0, 0, 0); PG8_SCHED; PG8_LDA(At, 0, 0); PG8_STAGE(PG8_SA(1, 1), a1 + hstep, voffA);
            PG8_WAIT_L(8); PG8_BAR; PG8_WAIT_L(0); PG8_MMA(0, 0, At, B0); PG8_BAR; PG8_SCHED;
            PG8_LDB(B1, 0, 1); PG8_STAGE(PG8_SB(0, 0), b2, voffB);
            PG8_BAR; PG8_WAIT_L(0); PG8_MMA(0, 1, At, B1); PG8_BAR;
            PG8_LDA(At, 0, 1); PG8_STAGE(PG8_SA(0, 0), a2, voffA);
            PG8_BAR; PG8_WAIT_L(0); PG8_MMA(1, 0, At, B0); PG8_BAR; PG8_SCHED;
            PG8_STAGE(PG8_SB(0, 1), b2 + hstep, voffB);
            PG8_WAIT_V(6); PG8_BAR; PG8_MMA(1, 1, At, B1); PG8_BAR;
            PG8_LDB(B0, 1, 0); PG8_SCHED; PG8_LDA(At, 1, 0); PG8_STAGE(PG8_SA(0, 1), a2 + hstep, voffA);
            PG8_WAIT_L(8); PG8_BAR; PG8_WAIT_L(0); PG8_MMA(0, 0, At, B0); PG8_BAR; PG8_SCHED;
            PG8_LDB(B1, 1, 1); PG8_STAGE(PG8_SB(1, 0), b3, voffB);
            PG8_BAR; PG8_WAIT_L(0); PG8_MMA(0, 1, At, B1); PG8_BAR;
            PG8_LDA(At, 1, 1); PG8_STAGE(PG8_SA(1, 0), a3, voffA);
            PG8_BAR; PG8_WAIT_L(0); PG8_MMA(1, 0, At, B0); PG8_BAR; PG8_SCHED;
            PG8_STAGE(PG8_SB(1, 1), b3 + hstep, voffB);
            PG8_WAIT_V(6); PG8_BAR; PG8_MMA(1, 1, At, B1); PG8_BAR;
            }
            if constexpr (KSEG) { if (t == 14 || t == 22) E.kscale(acc, ui, t == 14 ? 0 : 1, wr, fr); }
        }
        if constexpr (ALIGN_EPI) { if (wr == 0) PG8_BAR; }
        if constexpr (!Epi::AFTER_DRAIN) { if constexpr (KSEG) E.final(acc, cur, ui, wr, wc, fr, fq); else E(acc, cur, wr, wc, fr, fq); S.done(cur); }
        if (!has_next) break;
#pragma unroll
        for (int a = 0; a < 2; ++a)
#pragma unroll
            for (int b = 0; b < 2; ++b)
#pragma unroll
                for (int m = 0; m < 4; ++m)
#pragma unroll
                    for (int n = 0; n < 2; ++n) acc[a][b][m][n] = (f32x4){0.f, 0.f, 0.f, 0.f};
        cur = nxt; cA = nA; cB = nB; ++ui;
        if constexpr (ALIGN_EPI) { if (wr == 1) PG8_BAR; }
    }
    PG8_WAIT_V(0);
    if constexpr (!ALIGN_EPI) { if (wr == 0) PG8_BAR; }
    PG8_BAR;
    if constexpr (Epi::AFTER_DRAIN) { E.fused(acc, cur, wr, wc, fr, fq, lds, wid, lane); S.done(cur); }
#undef PG8_SA
#undef PG8_SB
#undef PG8_STAGE
#undef PG8_LDA
#undef PG8_LDB
#undef PG8_MMA
#undef PG8_WAIT_V
#undef PG8_WAIT_L
#undef PG8_BAR
#undef PG8_SCHED
}
}
namespace att {
using bf16 = __hip_bfloat16;
constexpr int   D = 128, NW = 8, QBLK = 32, KVBLK = 64;
constexpr float SCALE = 0.088388347648318440f;
constexpr float THR = 8.f;
constexpr size_t SHM_V = KVBLK * D * 2, SHM_K = KVBLK * D * 2, SHM_ATTN = 2 * SHM_V + 2 * SHM_K + NW * 64 * 4;
using bf16x8 = __attribute__((ext_vector_type(8))) short;
using s16x4  = __attribute__((ext_vector_type(4))) short;
using f32x16 = __attribute__((ext_vector_type(16))) float;
using f32x8  = __attribute__((ext_vector_type(8))) float;
using u32x4  = __attribute__((ext_vector_type(4))) unsigned;
#define KSWZ(row, colB) ((row) * 256 + ((colB) ^ (((row) & 7) << 4)))
#define SBAR() __builtin_amdgcn_sched_barrier(0)
__device__ __forceinline__ int crow(int r, int hi) { return (r & 3) + 8 * (r >> 2) + 4 * hi; }
__device__ __forceinline__ unsigned cvtpk(float lo, float hi) {
  unsigned r; asm volatile("v_cvt_pk_bf16_f32 %0, %1, %2" : "=v"(r) : "v"(lo), "v"(hi)); return r;
}
template <typename TIn> struct Stage;
template <> struct Stage<bf16>  { using T = bf16x8;
  __device__ static __forceinline__ T ld8(const bf16* p) { return *reinterpret_cast<const bf16x8*>(p); }
  __device__ static __forceinline__ bf16x8 tobf(T x) { return x; } };
template <> struct Stage<float> { using T = f32x8;
  __device__ static __forceinline__ T ld8(const float* p) { return *reinterpret_cast<const f32x8*>(p); }
  __device__ static __forceinline__ bf16x8 tobf(T x) {
    u32x4 w = {cvtpk(x[0], x[1]), cvtpk(x[2], x[3]), cvtpk(x[4], x[5]), cvtpk(x[6], x[7])}; return *reinterpret_cast<bf16x8*>(&w); } };

__device__ __forceinline__ void partialSM(f32x16& p0, f32x16& p1, float& m_reg, float& mn, float& alpha) {
  constexpr float C = SCALE * 1.4426950408889634f;
  float pmax = p0[0]; for (int r = 1; r < 16; ++r) pmax = fmaxf(pmax, p0[r]); for (int r = 0; r < 16; ++r) pmax = fmaxf(pmax, p1[r]);
  { auto rr = __builtin_amdgcn_permlane32_swap(__float_as_uint(pmax), __float_as_uint(pmax), false, false);
    pmax = fmaxf(__uint_as_float(rr[0]), __uint_as_float(rr[1])); }
  if (__builtin_expect(__all(pmax - m_reg <= THR / SCALE), 1)) { mn = m_reg; alpha = 1.f; }
  else { mn = fmaxf(m_reg, pmax); alpha = __builtin_amdgcn_exp2f((m_reg - mn) * C); m_reg = mn; }
  float mnC = -mn * C;
  for (int r = 0; r < 16; ++r) p0[r] = fmaf(p0[r], C, mnC); for (int r = 0; r < 16; ++r) p1[r] = fmaf(p1[r], C, mnC);
  for (int r = 0; r < 16; ++r) p0[r] = __builtin_amdgcn_exp2f(p0[r]);
}
__device__ __forceinline__ float psm_max0(const f32x16& p0) { float a = p0[0]; for (int r = 1; r < 16; ++r) a = fmaxf(a, p0[r]); return a; }
__device__ __forceinline__ void psm_decide(float pmax, const f32x16& p1, float& m_reg, float& mn, float& alpha) {
  constexpr float C = SCALE * 1.4426950408889634f;
  for (int r = 0; r < 16; ++r) pmax = fmaxf(pmax, p1[r]);
  { auto rr = __builtin_amdgcn_permlane32_swap(__float_as_uint(pmax), __float_as_uint(pmax), false, false);
    pmax = fmaxf(__uint_as_float(rr[0]), __uint_as_float(rr[1])); }
  if (__builtin_expect(__all(pmax - m_reg <= THR / SCALE), 1)) { mn = m_reg; alpha = 1.f; }
  else { mn = fmaxf(m_reg, pmax); alpha = __builtin_amdgcn_exp2f((m_reg - mn) * C); m_reg = mn; }
}
__device__ __forceinline__ void psm_scale(f32x16& p0, f32x16& p1, float mn) {
  constexpr float C = SCALE * 1.4426950408889634f; const float mnC = -mn * C;
  for (int r = 0; r < 16; ++r) p0[r] = fmaf(p0[r], C, mnC); for (int r = 0; r < 16; ++r) p1[r] = fmaf(p1[r], C, mnC);
}
__device__ __forceinline__ void psm_exp0(f32x16& p0) { for (int r = 0; r < 16; ++r) p0[r] = __builtin_amdgcn_exp2f(p0[r]); }
__device__ __forceinline__ void finishSM(f32x16& p0, f32x16& p1, float alpha, float& l_reg, bf16x8& pa0, bf16x8& pa1, bf16x8& pa2, bf16x8& pa3) {
  for (int r = 0; r < 16; ++r) p1[r] = __builtin_amdgcn_exp2f(p1[r]);
  float ps = 0; for (int r = 0; r < 16; ++r) ps += p0[r]; for (int r = 0; r < 16; ++r) ps += p1[r];
  { auto rr = __builtin_amdgcn_permlane32_swap(__float_as_uint(ps), __float_as_uint(ps), false, false);
    ps = __uint_as_float(rr[0]) + __uint_as_float(rr[1]); }
  l_reg = l_reg * alpha + ps;
#define PK4(P, BASE, OUT) do { unsigned a0 = cvtpk(P[BASE + 0], P[BASE + 1]), a1 = cvtpk(P[BASE + 2], P[BASE + 3]);   \
    unsigned b0 = cvtpk(P[BASE + 4], P[BASE + 5]), b1 = cvtpk(P[BASE + 6], P[BASE + 7]);                              \
    auto r0 = __builtin_amdgcn_permlane32_swap(a0, b0, false, false); auto r1 = __builtin_amdgcn_permlane32_swap(a1, b1, false, false); \
    u32x4 w = {r0[0], r1[0], r0[1], r1[1]}; OUT = *reinterpret_cast<bf16x8*>(&w); } while (0)
  PK4(p0, 0, pa0); PK4(p0, 8, pa1); PK4(p1, 0, pa2); PK4(p1, 8, pa3);
#undef PK4
}
__device__ __forceinline__ void qkt(f32x16& p0, f32x16& p1, const bf16* Ks, const bf16x8* qr, int r32, int hi) {
  p0 = f32x16{}; p1 = f32x16{};
  for (int d0 = 0; d0 < 8; ++d0) { int cb = (d0 * 16 + hi * 8) * 2;
    bf16x8 b0 = *reinterpret_cast<const bf16x8*>((const char*)Ks + KSWZ(r32, cb));
    bf16x8 b1 = *reinterpret_cast<const bf16x8*>((const char*)Ks + KSWZ(32 + r32, cb));
    p0 = __builtin_amdgcn_mfma_f32_32x32x16_bf16(b0, qr[d0], p0, 0, 0, 0);
    p1 = __builtin_amdgcn_mfma_f32_32x32x16_bf16(b1, qr[d0], p1, 0, 0, 0); }
}
__device__ __forceinline__ int v_st(int k, int c) { const int kk = (k & ~0xC) | ((k & 4) << 1) | ((k & 8) >> 1); return ((kk >> 3) * 4 + (c >> 5)) * 512 + ((kk & 7) * 32 + (c & 31)) * 2; }
__device__ __forceinline__ int v_rd_base(int lane) { return ((lane & 3) << 3) | (((lane >> 2) & 3) << 6) | (((lane >> 4) & 1) << 5) | (((lane >> 5) & 1) << 8); }
constexpr int v_rd_off(int d0, int ks, int half) { return d0 * 512 + ks * 4096 + half * 2048; }
template <int OFF> __device__ __forceinline__ s16x4 tr_read(int vb) {
  s16x4 r; asm volatile("ds_read_b64_tr_b16 %0, %1 offset:%2" : "=&v"(r) : "v"(vb), "i"(OFF) : "memory"); return r;
}
template <int D0> __device__ __forceinline__ void pv_one(f32x16& od, int vb, bf16x8 pa0, bf16x8 pa1, bf16x8 pa2, bf16x8 pa3) {
  const s16x4 l0 = tr_read<v_rd_off(D0, 0, 0)>(vb), h0 = tr_read<v_rd_off(D0, 0, 1)>(vb), l1 = tr_read<v_rd_off(D0, 1, 0)>(vb), h1 = tr_read<v_rd_off(D0, 1, 1)>(vb);
  const s16x4 l2 = tr_read<v_rd_off(D0, 2, 0)>(vb), h2 = tr_read<v_rd_off(D0, 2, 1)>(vb), l3 = tr_read<v_rd_off(D0, 3, 0)>(vb), h3 = tr_read<v_rd_off(D0, 3, 1)>(vb);
  asm volatile("s_waitcnt lgkmcnt(0)" ::: "memory"); SBAR();
#define PK(L, H) (bf16x8){L[0], L[1], L[2], L[3], H[0], H[1], H[2], H[3]}
  od = __builtin_amdgcn_mfma_f32_32x32x16_bf16(pa0, PK(l0, h0), od, 0, 0, 0);
  od = __builtin_amdgcn_mfma_f32_32x32x16_bf16(pa1, PK(l1, h1), od, 0, 0, 0);
  od = __builtin_amdgcn_mfma_f32_32x32x16_bf16(pa2, PK(l2, h2), od, 0, 0, 0);
  od = __builtin_amdgcn_mfma_f32_32x32x16_bf16(pa3, PK(l3, h3), od, 0, 0, 0);
#undef PK
}
__device__ __forceinline__ void pv_d0(f32x16* o, int vb, bf16x8 pa0, bf16x8 pa1, bf16x8 pa2, bf16x8 pa3) {
  pv_one<0>(o[0], vb, pa0, pa1, pa2, pa3); pv_one<1>(o[1], vb, pa0, pa1, pa2, pa3); pv_one<2>(o[2], vb, pa0, pa1, pa2, pa3); pv_one<3>(o[3], vb, pa0, pa1, pa2, pa3);
}
__device__ __forceinline__ void maskwin(f32x16& p0, f32x16& p1, int mb) {
#pragma unroll
  for (int r = 0; r < 16; ++r) { const int dk = mb + (r & 3) + 8 * (r >> 2);
    if ((unsigned)dk > 256u) p0[r] = -INFINITY; if ((unsigned)(dk + 32) > 256u) p1[r] = -INFINITY; }
}
constexpr int LDQ = 3072, LDO = 2048;
using f32x4 = __attribute__((ext_vector_type(4))) float;
__device__ __forceinline__ float bf2f(short v) { return __builtin_bit_cast(float, ((unsigned)(unsigned short)v) << 16); }
__device__ __forceinline__ void sincos_fast(float ang, float& sn, float& cs) { const float f = __builtin_amdgcn_fractf(ang * 0.15915494309189535f); sn = __builtin_amdgcn_sinf(f); cs = __builtin_amdgcn_cosf(f); }
template <int MODE, int QMODE>
__device__ __forceinline__ void attn_body(const bf16* __restrict__ Qb, const bf16* __restrict__ Kh, const bf16* __restrict__ Vh,
                                          unsigned short* __restrict__ Ob, float* __restrict__ hsp, int seq, int ldk, int qrel, const float* __restrict__ sinkp, int t0, const float* __restrict__ qg, char* lds) {
  using St = Stage<bf16>;
  int tid = threadIdx.x; asm volatile("" : "+v"(tid));
  const int wid = __builtin_amdgcn_readfirstlane(tid >> 6), lane = tid & 63, r32 = lane & 31, hi = lane >> 5;
  const int wrow = MODE ? (wid & 3) * QBLK : wid * QBLK, wcol = MODE ? (wid >> 2) * D : 0;
  bf16* V_lds = (bf16*)lds; bf16* K_lds = (bf16*)(lds + 2 * SHM_V);
  float* ws = (float*)(lds + 2 * SHM_V + 2 * SHM_K) + wid * 64; float* li_l = ws; float* al_l = ws + 32;
  float m_reg = MODE ? sinkp[wid >> 2] * (1.0f / SCALE) : -1e30f, l_reg = MODE ? 1.f : 0.f; bf16x8 qr[8];
  const bf16* Qw = Qb + (long)(wrow + r32) * LDQ + wcol + hi * 8;
#pragma unroll
  for (int d0 = 0; d0 < 8; ++d0) qr[d0] = St::ld8(Qw + d0 * 16);
  if constexpr (QMODE != 0) {
    const int t = t0 + wrow + r32; constexpr float L2T = 13.287712379549449f;
    if constexpr (QMODE == 2) {
      float ssq = 0.f;
#pragma unroll
      for (int d0 = 0; d0 < 8; ++d0)
#pragma unroll
        for (int j = 0; j < 8; ++j) { const float x = bf2f(qr[d0][j]); ssq += x * x; }
      { auto rr = __builtin_amdgcn_permlane32_swap(__float_as_uint(ssq), __float_as_uint(ssq), false, false); ssq = __uint_as_float(rr[0]) + __uint_as_float(rr[1]); }
      const float rn = 1.0f / sqrtf(ssq * (1.0f / 128.0f) + 1e-6f);
      const float posr = (float)(t >> 6), posc = (float)(t & 63);
#pragma unroll
      for (int hf = 0; hf < 2; ++hf)
#pragma unroll
        for (int dd = 0; dd < 2; ++dd) { const int da = hf * 4 + dd, db = da + 2;
          const f32x4 ga0 = *(const f32x4*)(qg + da * 16 + hi * 8), ga1 = *(const f32x4*)(qg + da * 16 + hi * 8 + 4), gb0 = *(const f32x4*)(qg + db * 16 + hi * 8), gb1 = *(const f32x4*)(qg + db * 16 + hi * 8 + 4);
          float ya[8], yb[8];
#pragma unroll
          for (int j = 0; j < 8; ++j) { const int i = dd * 16 + hi * 8 + j; const float inv = __builtin_amdgcn_exp2f(-(float)i * (L2T / 32.0f));
            float sn, cs; sincos_fast((hf ? posc : posr) * inv, sn, cs);
            const float x1 = bf2f(qr[da][j]) * rn * (j < 4 ? ga0[j & 3] : ga1[j & 3]), x2 = bf2f(qr[db][j]) * rn * (j < 4 ? gb0[j & 3] : gb1[j & 3]);
            ya[j] = x1 * cs - x2 * sn; yb[j] = x2 * cs + x1 * sn; }
          u32x4 wa = {cvtpk(ya[0], ya[1]), cvtpk(ya[2], ya[3]), cvtpk(ya[4], ya[5]), cvtpk(ya[6], ya[7])}, wb = {cvtpk(yb[0], yb[1]), cvtpk(yb[2], yb[3]), cvtpk(yb[4], yb[5]), cvtpk(yb[6], yb[7])};
          qr[da] = *reinterpret_cast<bf16x8*>(&wa); qr[db] = *reinterpret_cast<bf16x8*>(&wb); SBAR(); }
    } else {
      const float pos = (float)t;
#pragma unroll
      for (int d0 = 0; d0 < 4; ++d0) { float ya[8], yb[8];
#pragma unroll
        for (int j = 0; j < 8; ++j) { const int i = d0 * 16 + hi * 8 + j; const float inv = __builtin_amdgcn_exp2f(-(float)i * (L2T / 64.0f));
          float sn, cs; sincos_fast(pos * inv, sn, cs);
          const float x1 = bf2f(qr[d0][j]), x2 = bf2f(qr[d0 + 4][j]);
          ya[j] = x1 * cs - x2 * sn; yb[j] = x2 * cs + x1 * sn; }
        u32x4 wa = {cvtpk(ya[0], ya[1]), cvtpk(ya[2], ya[3]), cvtpk(ya[4], ya[5]), cvtpk(ya[6], ya[7])}, wb = {cvtpk(yb[0], yb[1]), cvtpk(yb[2], yb[3]), cvtpk(yb[4], yb[5]), cvtpk(yb[6], yb[7])};
        qr[d0] = *reinterpret_cast<bf16x8*>(&wa); qr[d0 + 4] = *reinterpret_cast<bf16x8*>(&wb); SBAR(); }
    }
  }
#pragma unroll
  for (int d0 = 0; d0 < 8; ++d0) asm volatile("" : "+v"(qr[d0]));
  asm volatile("" ::: "memory"); SBAR();
  f32x16 o[4] = {};
  const int sr = tid >> 4, sc = (tid & 15) * 8, vst0 = v_st(sr, sc), vst1 = v_st(32 + sr, sc);
  const int vb0 = (int)(uintptr_t)V_lds + v_rd_base(lane);
  const unsigned toff = (unsigned)(sr * ldk + sc) * 2u; const long h32 = (long)ldk * 64;
  constexpr int SDEPTH = (MODE == 0 && QMODE == 2) ? 2 : 1;
  struct { typename St::T vs0, vs1, ks0, ks1; } sr_[SDEPTH];
#define SLOAD(i, k0) do { const long to_ = (long)(k0) * ldk * 2; const char* vt_ = (const char*)Vh + to_; const char* kt_ = (const char*)Kh + to_; \
    sr_[i].vs0 = *(const bf16x8*)(vt_ + toff); sr_[i].vs1 = *(const bf16x8*)(vt_ + h32 + toff); \
    sr_[i].ks0 = *(const bf16x8*)(kt_ + toff); sr_[i].ks1 = *(const bf16x8*)(kt_ + h32 + toff); } while (0)
#define SWRITE(b, i) do { *(bf16x8*)((char*)V_lds + (b) * SHM_V + vst0) = St::tobf(sr_[i].vs0);          \
    *(bf16x8*)((char*)V_lds + (b) * SHM_V + vst1) = St::tobf(sr_[i].vs1); int kc = sc * 2;               \
    *(bf16x8*)((char*)K_lds + (b) * SHM_K + KSWZ(sr, kc)) = St::tobf(sr_[i].ks0);                       \
    *(bf16x8*)((char*)K_lds + (b) * SHM_K + KSWZ(32 + sr, kc)) = St::tobf(sr_[i].ks1); } while (0)
#define SWAIT() do { if constexpr (SDEPTH == 2) asm volatile("s_waitcnt vmcnt(4)" ::: "memory"); else asm volatile("s_waitcnt vmcnt(0)" ::: "memory"); } while (0)
#define RESC(a) do { if (__any((a) < 1.f)) { if (hi == 0) al_l[r32] = (a); asm volatile("s_waitcnt lgkmcnt(0)" ::: "memory"); \
    for (int d = 0; d < 4; ++d) for (int r = 0; r < 16; ++r) o[d][r] *= al_l[crow(r, hi)]; } } while (0)
  const int qw0 = qrel + wrow;
#define MASK(P0, P1, k0) do { if constexpr (MODE == 1) { const int k0_ = (k0); \
    if ((k0_ + 63 - qw0 > 128) || (k0_ - (qw0 + 31) < -128)) maskwin(P0, P1, k0_ - (qw0 + r32) + 128 + 4 * hi); } } while (0)
#define PVSM(VB, P0, P1, K0, MN, AL) do { MASK(P0, P1, K0); float pm_; \
    pv_one<0>(o[0], VB, pa0, pa1, pa2, pa3); pm_ = psm_max0(P0); \
    pv_one<1>(o[1], VB, pa0, pa1, pa2, pa3); psm_decide(pm_, P1, m_reg, MN, AL); \
    pv_one<2>(o[2], VB, pa0, pa1, pa2, pa3); psm_scale(P0, P1, MN); asm volatile("" : "+v"(P0), "+v"(P1)); \
    pv_one<3>(o[3], VB, pa0, pa1, pa2, pa3); psm_exp0(P0); asm volatile("" : "+v"(P0)); SBAR(); } while (0)
  if (wid >= 4) __builtin_amdgcn_s_setprio(1);
  f32x16 pA0, pA1, pB0, pB1; float mnA, mnB, alA, alB; bf16x8 pa0, pa1, pa2, pa3; const int NT = seq / KVBLK;
  constexpr int SE = 0, SO = SDEPTH - 1;
  SLOAD(SE, 0); asm volatile("s_waitcnt vmcnt(0)" ::: "memory"); SWRITE(0, SE); __syncthreads();
  qkt(pA0, pA1, K_lds, qr, r32, hi); MASK(pA0, pA1, 0); partialSM(pA0, pA1, m_reg, mnA, alA);
  SLOAD(SO, KVBLK); if constexpr (SDEPTH == 2) { if (2 < NT) SLOAD(SE, 2 * KVBLK); }
  SWAIT(); SWRITE(1, SO); __syncthreads();
  for (int j = 1; j + 1 < NT; j += 2) {
    SBAR(); qkt(pB0, pB1, (bf16*)((char*)K_lds + SHM_K), qr, r32, hi);
    finishSM(pA0, pA1, alA, l_reg, pa0, pa1, pa2, pa3); SBAR();
    SLOAD(SO, (j + SDEPTH) * KVBLK); SBAR();
    PVSM(vb0, pB0, pB1, j * KVBLK, mnB, alB);
    __syncthreads(); SWAIT(); SWRITE(0, SE);
    RESC(alB); __syncthreads();
    SBAR(); qkt(pA0, pA1, K_lds, qr, r32, hi);
    finishSM(pB0, pB1, alB, l_reg, pa0, pa1, pa2, pa3); SBAR();
    if (SDEPTH == 1 || j + 3 < NT) SLOAD(SE, (j + 1 + SDEPTH) * KVBLK); SBAR();
    PVSM(vb0 + (int)SHM_V, pA0, pA1, (j + 1) * KVBLK, mnA, alA);
    __syncthreads(); SWAIT(); SWRITE(1, SO);
    RESC(alA); __syncthreads();
  }
  SBAR(); qkt(pB0, pB1, (bf16*)((char*)K_lds + SHM_K), qr, r32, hi);
  finishSM(pA0, pA1, alA, l_reg, pa0, pa1, pa2, pa3); SBAR();
  PVSM(vb0, pB0, pB1, (NT - 1) * KVBLK, mnB, alB);
  __syncthreads(); RESC(alB);
  finishSM(pB0, pB1, alB, l_reg, pa0, pa1, pa2, pa3); SBAR();
  pv_d0(o, vb0 + (int)SHM_V, pa0, pa1, pa2, pa3);
  __builtin_amdgcn_s_setprio(0);
  if (hi == 0) li_l[r32] = l_reg; asm volatile("s_waitcnt lgkmcnt(0)" ::: "memory");
  float rli[16];
#pragma unroll
  for (int r = 0; r < 16; ++r) rli[r] = __builtin_amdgcn_rcpf(li_l[crow(r, hi)]);
  unsigned zz_ = 0u; asm volatile("" : "+v"(zz_)); const int r32e = (int)__builtin_amdgcn_mbcnt_hi(~0u, __builtin_amdgcn_mbcnt_lo(~0u, zz_)) & 31;
  unsigned short* Ow = Ob + (long)wrow * LDO + wcol + r32e;
#pragma unroll
  for (int r = 0; r < 16; ++r) { int orow = crow(r, hi);
#pragma unroll
    for (int d0 = 0; d0 < 4; ++d0) { const float v = o[d0][r] * rli[r]; Ow[(long)orow * LDO + d0 * 32] = (unsigned short)(cvtpk(v, v) & 0xffffu); o[d0][r] = v * v; } }
  { float* hw = hsp + (long)wrow * 16 + (MODE ? (wid >> 2) : 0);
#pragma unroll
    for (int r = 0; r < 16; ++r) { float q = (o[0][r] + o[1][r]) + (o[2][r] + o[3][r]);
      q += __builtin_bit_cast(float, __builtin_amdgcn_update_dpp(0, __builtin_bit_cast(int, q), 0xB1, 0xF, 0xF, true));
      q += __builtin_bit_cast(float, __builtin_amdgcn_update_dpp(0, __builtin_bit_cast(int, q), 0x4E, 0xF, 0xF, true));
      q += __builtin_bit_cast(float, __builtin_amdgcn_update_dpp(0, __builtin_bit_cast(int, q), 0x141, 0xF, 0xF, true));
      q += __builtin_bit_cast(float, __builtin_amdgcn_update_dpp(0, __builtin_bit_cast(int, q), 0x140, 0xF, 0xF, true));
      { float q2 = q; asm volatile("" : "+v"(q2)); auto rr = __builtin_amdgcn_permlane16_swap(__float_as_uint(q), __float_as_uint(q2), false, false); const unsigned a_ = rr[0], b_ = rr[1]; q = __uint_as_float(a_) + __uint_as_float(b_); }
      if (r32e == r) hw[(long)crow(r, hi) * 16] = q; } }
  __syncthreads();
#undef SLOAD
#undef SWRITE
#undef SWAIT
#undef RESC
#undef MASK
#undef PVSM
}
#undef KSWZ
#undef SBAR
}
#define LAS __attribute__((address_space(3)))
typedef unsigned short bf16_t;
typedef unsigned v4u __attribute__((ext_vector_type(4)));
typedef unsigned v2u __attribute__((ext_vector_type(2)));
typedef float f32x4 __attribute__((ext_vector_type(4)));
constexpr int MTOK = 32768, DM = 2048, INW = 3072, DFF = 5632, NGU = 2 * DFF, MEMR = 768, MKV = 1024, NWAVES = 8;
constexpr int SEQ0 = 16384, SEQS = 8192;
constexpr float EPS = 1e-6f;
constexpr size_t MiB = 1u << 20;
constexpr size_t WS_RSTD1 = 0, WS_SS2 = 128 * 1024, WS_SS3 = 256 * 1024, WS_RSTDM = 384 * 1024;
constexpr size_t WS_WIN = 2 * MiB, WS_WMEM = 14 * MiB, WS_WOUT = 18 * MiB, WS_WGU = 26 * MiB, WS_WD = 70 * MiB;
constexpr size_t WS_KVM = 92 * MiB, WS_MEMB = 94 * MiB;
constexpr size_t WS_XB = 98 * MiB;
constexpr size_t WS_PROJ = 226 * MiB;
constexpr size_t WS_X1B = 290 * MiB;
constexpr size_t WS_HS = 418 * MiB;
constexpr size_t WS_END = 420 * MiB;
constexpr int LDS_BYTES = 147456;

__device__ __forceinline__ unsigned f2bf(float f) { unsigned u = __builtin_bit_cast(unsigned, f); return (u + 0x7fffu + ((u >> 16) & 1u)) >> 16; }
__device__ __forceinline__ unsigned pk2(float lo, float hi) { return pg8::cvt_pk_bf16(lo, hi); }
__device__ __forceinline__ float bflo(unsigned w) { return __builtin_bit_cast(float, w << 16); }
__device__ __forceinline__ float bfhi(unsigned w) { return __builtin_bit_cast(float, w & 0xffff0000u); }
__device__ __forceinline__ float wave_sum(float v) {
#pragma unroll
    for (int o = 1; o < 64; o <<= 1) v += __shfl_xor(v, o);
    return v;
}
template <int CTRL> __device__ __forceinline__ float dppf(float v) { return __builtin_bit_cast(float, __builtin_amdgcn_update_dpp(0, __builtin_bit_cast(int, v), CTRL, 0xF, 0xF, true)); }
__device__ __forceinline__ float sum_x16(float v) { float v2 = v; asm volatile("" : "+v"(v2));
    auto rr = __builtin_amdgcn_permlane16_swap(__builtin_bit_cast(unsigned, v), __builtin_bit_cast(unsigned, v2), false, false); const unsigned a_ = rr[0], b_ = rr[1]; return __uint_as_float(a_) + __uint_as_float(b_); }
__device__ __forceinline__ float sum_x32(float v) { float v2 = v; asm volatile("" : "+v"(v2));
    auto rr = __builtin_amdgcn_permlane32_swap(__builtin_bit_cast(unsigned, v), __builtin_bit_cast(unsigned, v2), false, false); const unsigned a_ = rr[0], b_ = rr[1]; return __uint_as_float(a_) + __uint_as_float(b_); }
__device__ __forceinline__ float wave_sum_dpp(float v) {
    v += dppf<0xB1>(v); v += dppf<0x4E>(v); v += dppf<0x141>(v); v += dppf<0x140>(v);
    return sum_x32(sum_x16(v));
}
#define LDS_WAIT() asm volatile("s_waitcnt lgkmcnt(0)" ::: "memory")

namespace pg8 {
struct EpiScaleBf16 {
    static constexpr bool PERM = true, AFTER_DRAIN = false;
    bf16_t* O; int ldc; const float* rs;
    __device__ __forceinline__ void operator()(const f32x4 (&acc)[2][2][4][2], const Unit& u, int wr, int wc, int fr, int fq) const {
        const int row0 = u.pm * BM + wr * 64 + fr, col0 = u.pn * BM + wc * 32 + 8 * fq;
#pragma unroll
        for (int ai = 0; ai < 2; ++ai)
#pragma unroll
            for (int m = 0; m < 4; ++m) { const int row = row0 + ai * HALF + m * 16; const float s = rs[row]; bf16_t* rowp = O + (size_t)row * ldc + col0;
#pragma unroll
                for (int bj = 0; bj < 2; ++bj) { const f32x4 v0 = acc[ai][bj][m][0] * s, v1 = acc[ai][bj][m][1] * s;
                    u32x4 w; w.x = cvt_pk_bf16(v0[0], v0[1]); w.y = cvt_pk_bf16(v0[2], v0[3]); w.z = cvt_pk_bf16(v1[0], v1[1]); w.w = cvt_pk_bf16(v1[2], v1[3]);
                    *(u32x4*)(rowp + bj * HALF) = w; } }
    }
};
struct EpiResidX {
    static constexpr bool PERM = true, AFTER_DRAIN = false;
    const float* srcA; const float* srcB;
    bf16_t* xb; float* ss; const PG8_LAS float* tab;
    __device__ __forceinline__ void kscale(f32x4 (&acc)[2][2][4][2], int ui, int which, int wr, int fr) const {
#pragma unroll
        for (int ai = 0; ai < 2; ++ai)
#pragma unroll
            for (int m = 0; m < 4; ++m) { const float f = tab[(ui * 256 + ai * HALF + wr * 64 + m * 16 + fr) * 4 + which];
#pragma unroll
                for (int bj = 0; bj < 2; ++bj)
#pragma unroll
                    for (int n = 0; n < 2; ++n) acc[ai][bj][m][n] = acc[ai][bj][m][n] * f; }
    }
    __device__ __forceinline__ void final(const f32x4 (&acc)[2][2][4][2], const Unit& u, int ui, int wr, int wc, int fr, int fq) const {
        const int row0 = u.pm * BM + wr * 64 + fr, col0 = u.pn * BM + wc * 32 + 8 * fq;
#pragma unroll
        for (int ai = 0; ai < 2; ++ai)
#pragma unroll
            for (int m = 0; m < 4; ++m) { const int row = row0 + ai * HALF + m * 16; const float f = tab[(ui * 256 + ai * HALF + wr * 64 + m * 16 + fr) * 4 + 2];
                const float* src = (row < 16384 ? srcA + (size_t)row * 2048 : srcB + (size_t)(row - 16384) * 2048) + col0; float s = 0.f;
#pragma unroll
                for (int bj = 0; bj < 2; ++bj) { const f32x4 v0 = acc[ai][bj][m][0] * f + *(const f32x4*)(src + bj * HALF), v1 = acc[ai][bj][m][1] * f + *(const f32x4*)(src + bj * HALF + 4);
                    s += (v0[0] * v0[0] + v0[1] * v0[1]) + (v0[2] * v0[2] + v0[3] * v0[3]) + (v1[0] * v1[0] + v1[1] * v1[1]) + (v1[2] * v1[2] + v1[3] * v1[3]);
                    u32x4 w; w.x = cvt_pk_bf16(v0[0], v0[1]); w.y = cvt_pk_bf16(v0[2], v0[3]); w.z = cvt_pk_bf16(v1[0], v1[1]); w.w = cvt_pk_bf16(v1[2], v1[3]);
                    *(u32x4*)(xb + (size_t)row * 2048 + col0 + bj * HALF) = w; }
                s = sum_x32(sum_x16(s)); asm volatile("" : "+v"(s));
                if (fq == 0) atomicAdd(ss + row, s); }
    }
    __device__ __forceinline__ void operator()(const f32x4 (&acc)[2][2][4][2], const Unit& u, int wr, int wc, int fr, int fq) const {}
};
struct EpiResidB {
    static constexpr bool PERM = true, AFTER_DRAIN = false;
    bf16_t* xb; float* ss; int row_base;
    __device__ __forceinline__ void operator()(const f32x4 (&acc)[2][2][4][2], const Unit& u, int wr, int wc, int fr, int fq) const {
        const int row0 = row_base + u.pm * BM + wr * 64 + fr, col0 = u.pn * BM + wc * 32 + 8 * fq;
#pragma unroll
        for (int ai = 0; ai < 2; ++ai)
#pragma unroll
            for (int m = 0; m < 4; ++m) { const int row = row0 + ai * HALF + m * 16; bf16_t* rp = xb + (size_t)row * 2048 + col0; float s = 0.f;
#pragma unroll
                for (int bj = 0; bj < 2; ++bj) { const u32x4 x = *(const u32x4*)(rp + bj * HALF); float v[8];
#pragma unroll
                    for (int e = 0; e < 4; ++e) { v[2 * e] = __builtin_bit_cast(float, x[e] << 16) + acc[ai][bj][m][e >> 1][(2 * e) & 3]; v[2 * e + 1] = __builtin_bit_cast(float, x[e] & 0xffff0000u) + acc[ai][bj][m][e >> 1][(2 * e + 1) & 3]; }
#pragma unroll
                    for (int e = 0; e < 8; ++e) s += v[e] * v[e];
                    u32x4 w; w.x = cvt_pk_bf16(v[0], v[1]); w.y = cvt_pk_bf16(v[2], v[3]); w.z = cvt_pk_bf16(v[4], v[5]); w.w = cvt_pk_bf16(v[6], v[7]);
                    *(u32x4*)(rp + bj * HALF) = w; }
                s = sum_x32(sum_x16(s)); asm volatile("" : "+v"(s));
                if (fq == 0) atomicAdd(ss + row, s); }
    }
};
struct EpiSwiglu {
    static constexpr bool PERM = true, AFTER_DRAIN = false;
    bf16_t* act; const float* ss; int row_base;
    __device__ __forceinline__ void operator()(const f32x4 (&acc)[2][2][4][2], const Unit& u, int wr, int wc, int fr, int fq) const {
        const int row0 = u.pm * BM + wr * 64 + fr, col0 = u.pn * HALF + wc * 32 + 8 * fq;
#pragma unroll
        for (int ai = 0; ai < 2; ++ai)
#pragma unroll
            for (int m = 0; m < 4; ++m) { const int row = row0 + ai * HALF + m * 16; const float rs = __builtin_amdgcn_rsqf(ss[row_base + row] * (1.0f / 2048.0f) + 1e-6f);
                float a[8];
#pragma unroll
                for (int n = 0; n < 2; ++n)
#pragma unroll
                    for (int j = 0; j < 4; ++j) { const float g = acc[ai][0][m][n][j] * rs, uu = acc[ai][1][m][n][j] * rs;
                        a[n * 4 + j] = g * uu * __builtin_amdgcn_rcpf(1.0f + __builtin_amdgcn_exp2f(-1.4426950408889634f * g)); }
                u32x4 w; w.x = cvt_pk_bf16(a[0], a[1]); w.y = cvt_pk_bf16(a[2], a[3]); w.z = cvt_pk_bf16(a[4], a[5]); w.w = cvt_pk_bf16(a[6], a[7]);
                *(u32x4*)(act + (size_t)row * 5632 + col0) = w; }
    }
};
}

struct TItem { const float* W; const float* gain; bf16_t* WT; int K, N, k0, n0, drow0; };
__device__ __forceinline__ void titem_load(const TItem& t, float (&r)[32], int lane) {
    const float* p = t.W + (size_t)(t.k0 + (lane >> 5)) * t.N + t.n0 + (lane & 31);
#pragma unroll
    for (int i = 0; i < 32; ++i) r[i] = __builtin_nontemporal_load(p + (size_t)(2 * i) * t.N);
}
__device__ __forceinline__ void titem_store(const TItem& t, const float (&r)[32], LAS float* scr, int lane) {
#pragma unroll
    for (int i = 0; i < 32; ++i) scr[(2 * i + (lane >> 5)) * 33 + (lane & 31)] = r[i];
    LDS_WAIT(); asm volatile("" ::: "memory");
    const int c = lane & 7;
    f32x4 g0 = {1.f, 1.f, 1.f, 1.f}, g1 = g0;
    if (t.gain) { g0 = *(const f32x4*)(t.gain + t.k0 + 8 * c); g1 = *(const f32x4*)(t.gain + t.k0 + 8 * c + 4); }
#pragma unroll
    for (int j = 0; j < 4; ++j) { const int n = (lane >> 3) + 8 * j; const LAS float* s = scr + (8 * c) * 33 + n;
        v4u o; o.x = pk2(s[0 * 33] * g0.x, s[1 * 33] * g0.y); o.y = pk2(s[2 * 33] * g0.z, s[3 * 33] * g0.w); o.z = pk2(s[4 * 33] * g1.x, s[5 * 33] * g1.y); o.w = pk2(s[6 * 33] * g1.z, s[7 * 33] * g1.w);
        *(v4u*)(t.WT + (size_t)(t.drow0 + n) * t.K + t.k0 + 8 * c) = o; }
    LDS_WAIT(); asm volatile("" ::: "memory");
}
__device__ __forceinline__ void rows4_to_bf16(const float* __restrict__ x0, bf16_t* __restrict__ o0, float* __restrict__ rstd_out, int lane) {
    f32x4 v[4][8];
#pragma unroll
    for (int r = 0; r < 4; ++r)
#pragma unroll
        for (int j = 0; j < 8; ++j) v[r][j] = __builtin_nontemporal_load((const f32x4*)(x0 + (size_t)r * 2048) + lane + 64 * j);
#pragma unroll
    for (int r = 0; r < 4; ++r) { float s = 0.f;
#pragma unroll
        for (int j = 0; j < 8; ++j) s += (v[r][j].x * v[r][j].x + v[r][j].y * v[r][j].y) + (v[r][j].z * v[r][j].z + v[r][j].w * v[r][j].w);
        s = wave_sum(s);
        if (lane == 0) rstd_out[r] = 1.0f / sqrtf(s * (1.0f / 2048.0f) + EPS);
        v2u* o8 = (v2u*)(o0 + (size_t)r * 2048) + lane;
#pragma unroll
        for (int j = 0; j < 8; ++j) { v2u w; w.x = pk2(v[r][j].x, v[r][j].y); w.y = pk2(v[r][j].z, v[r][j].w); o8[64 * j] = w; } }
}
__device__ __forceinline__ void sincos_ang(float ang, float& s, float& c) {
    double t = (double)ang * 0.15915494309189535; t -= __builtin_floor(t); const float f = (float)t;
    s = __builtin_amdgcn_sinf(f); c = __builtin_amdgcn_cosf(f);
}

#ifndef ATT_MASK
#define ATT_MASK 7
#endif
struct Params { const float* in[17]; float* out; unsigned char* ws; int ph_lo, ph_hi; };

__global__ void __launch_bounds__(NWAVES * 64, 2) hymba_fwd(Params P) {
    __builtin_assume(__builtin_amdgcn_workitem_id_y() == 0); __builtin_assume(__builtin_amdgcn_workitem_id_z() == 0);
    extern __shared__ __attribute__((aligned(16))) unsigned char lds[];
    cg::grid_group grid = cg::this_grid();
    const int tid = threadIdx.x, lane = tid & 63, wave = __builtin_amdgcn_readfirstlane(tid >> 6);
    const int G = gridDim.x, cu = blockIdx.x;
    const int gw = cu * NWAVES + wave, NGW = G * NWAVES;
    unsigned char* ws = P.ws;
    float* rstd1 = (float*)(ws + WS_RSTD1); float* ss2 = (float*)(ws + WS_SS2); float* ss3 = (float*)(ws + WS_SS3); float* rstdm = (float*)(ws + WS_RSTDM);
    bf16_t* WinT = (bf16_t*)(ws + WS_WIN); bf16_t* WmemT = (bf16_t*)(ws + WS_WMEM); bf16_t* WoutT = (bf16_t*)(ws + WS_WOUT); bf16_t* WguT = (bf16_t*)(ws + WS_WGU); bf16_t* WdT = (bf16_t*)(ws + WS_WD);
    bf16_t* kvm = (bf16_t*)(ws + WS_KVM); bf16_t* memb = (bf16_t*)(ws + WS_MEMB);
    bf16_t* xb = (bf16_t*)(ws + WS_XB); bf16_t* Obuf = xb; bf16_t* act = xb;
    float* hs = (float*)(ws + WS_HS);
    bf16_t* proj = (bf16_t*)(ws + WS_PROJ); bf16_t* x1b = (bf16_t*)(ws + WS_X1B);
    const float* x_prompt = P.in[0]; const float* x_sample = P.in[1];
    const int lo = P.ph_lo, hi_ = P.ph_hi;
#ifndef PH_MASK
#define PH_MASK 0x7ff
#endif
#define IN(k) (((PH_MASK >> (k)) & 1) && lo <= (k) && (k) < hi_)
#define SEAM(k) do { if (IN(k) && IN((k) + 1)) grid.sync(); } while (0)

#ifdef PROBE_SYNCS
    for (int i_ = 0; i_ < PROBE_SYNCS; ++i_) grid.sync();
#endif
    if (IN(0)) {
        for (int i = cu * 512 + tid; i < MTOK; i += G * 512) { ss2[i] = 0.f; ss3[i] = 0.f; }
        LAS float* scr = (LAS float*)((LAS unsigned char*)lds + wave * 16384);
        constexpr int I_IN = 32 * 96, I_MEM = 32 * 32, I_OUT = 32 * 64, I_GU = 32 * 352, I_D = 88 * 64;
        constexpr int NITEMS = I_IN + I_MEM + I_OUT + I_GU + I_D;
        auto decode = [&](int it) -> TItem {
            int r = it; TItem t;
            if (r < I_IN) { const int kb = r / 96, nb = r % 96; t = TItem{P.in[6], P.in[4], WinT, 2048, INW, 64 * kb, 32 * nb, 32 * nb}; return t; } r -= I_IN;
            if (r < I_MEM) { const int kb = r / 32, nb = r % 32; t = TItem{P.in[7], P.in[5], WmemT, 2048, MKV, 64 * kb, 32 * nb, 32 * nb}; return t; } r -= I_MEM;
            if (r < I_OUT) { const int kb = r / 64, nb = r % 64; t = TItem{P.in[12], P.in[11], WoutT, 2048, DM, 64 * kb, 32 * nb, 32 * nb}; return t; } r -= I_OUT;
            if (r < I_GU) { const int kb = r / 352, nb = r % 352; const int n0 = 32 * nb; const int nn = n0 < DFF ? n0 : n0 - DFF;
                const int drow = (nn >> 7) * 256 + (n0 < DFF ? 0 : 128) + (nn & 127);
                t = TItem{P.in[14], P.in[13], WguT, 2048, NGU, 64 * kb, n0, drow}; return t; } r -= I_GU;
            { const int kb = r / 64, nb = r % 64; t = TItem{P.in[15], nullptr, WdT, DFF, DM, 64 * kb, 32 * nb, 32 * nb}; return t; }
        };
        {
            float ra[32], rb[32]; int it = gw;
            TItem ta, tb;
            if (it < NITEMS) { ta = decode(it); titem_load(ta, ra, lane); }
            while (it < NITEMS) {
                const int itb = it + NGW; if (itb < NITEMS) { tb = decode(itb); titem_load(tb, rb, lane); }
                titem_store(ta, ra, scr, lane);
                if (itb >= NITEMS) break;
                const int ita = itb + NGW; if (ita < NITEMS) { ta = decode(ita); titem_load(ta, ra, lane); }
                titem_store(tb, rb, scr, lane);
                it = ita;
            }
        }
        for (int m = gw * 4; m < MTOK; m += NGW * 4) rows4_to_bf16(m < SEQ0 ? x_prompt + (size_t)m * DM : x_sample + (size_t)(m - SEQ0) * DM, xb + (size_t)m * DM, rstd1 + m, lane);
        for (int m = gw * 4; m < MEMR; m += NGW * 4) rows4_to_bf16(m < 256 ? P.in[2] + (size_t)m * DM : P.in[3] + (size_t)(m - 256) * DM, memb + (size_t)m * DM, rstdm + m, lane);
    }
    SEAM(0);

    if (IN(1)) {
        { pg8::Gemm g{xb, WinT, MTOK, INW, DM}; pg8::StaticOrder S; S.init(MTOK, INW, G, cu);
          pg8::EpiScaleBf16 E{proj, INW, rstd1};
          pg8::gemm_phase<pg8::EpiScaleBf16, pg8::StaticOrder, true, true>((LAS unsigned char*)lds, g, S, E); }
    }
    SEAM(1);

    if (IN(2)) {
        int tidf_ = threadIdx.x; asm volatile("" : "+v"(tidf_)); const int lane = tidf_ & 63, wave = __builtin_amdgcn_readfirstlane(tidf_ >> 6), gw = cu * NWAVES + wave; (void)lane; (void)gw;
        for (int task = wave * G + cu; task < 768; task += NWAVES * G) {
            const int mt = task >> 4, nt = task & 15, fr = lane & 15, fq = lane >> 4;
            const bf16_t* ap = memb + (size_t)(mt * 16 + fr) * DM + fq * 8;
            const bf16_t* bp = WmemT + (size_t)(nt * 64 + fr) * DM + fq * 8;
            f32x4 acc[4] = {};
#pragma unroll 4
            for (int k0 = 0; k0 < DM; k0 += 32) {
                const pg8::bf16x8 a = *(const pg8::bf16x8*)(ap + k0);
#pragma unroll
                for (int j = 0; j < 4; ++j) { const pg8::bf16x8 b = *(const pg8::bf16x8*)(bp + (size_t)j * 16 * DM + k0);
                    acc[j] = __builtin_amdgcn_mfma_f32_16x16x32_bf16(a, b, acc[j], 0, 0, 0); }
            }
#pragma unroll
            for (int i = 0; i < 4; ++i) { const int row = mt * 16 + fq * 4 + i; const float rs = rstdm[row];
#pragma unroll
                for (int j = 0; j < 4; ++j) kvm[(size_t)row * MKV + nt * 64 + j * 16 + fr] = (bf16_t)f2bf(acc[j][i] * rs); }
        }
        const float L2T = 13.287712379549449f;
        const int l5 = lane & 31, l4 = lane & 15;
        const float invA0 = exp2f(-(float)(2 * l5) * (L2T / 64.0f)), invA1 = exp2f(-(float)(2 * l5 + 1) * (L2T / 64.0f));
        const float invB0 = exp2f(-(float)(2 * l4) * (L2T / 32.0f)), invB1 = exp2f(-(float)(2 * l4 + 1) * (L2T / 32.0f));
        const float sgnA = (lane & 32) ? 1.f : -1.f, sgnB = (lane & 16) ? 1.f : -1.f;
        const float kg0 = P.in[10][2 * lane], kg1 = P.in[10][2 * lane + 1];
        for (int row0 = gw * 4; row0 < MTOK; row0 += NGW * 4) {
            unsigned wq[4][4];
#pragma unroll
            for (int r = 0; r < 4; ++r) { const unsigned* prow = (const unsigned*)(proj + (size_t)(row0 + r) * INW);
#pragma unroll
                for (int h = 0; h < 2; ++h) { wq[r][h] = prow[512 + h * 64 + lane]; wq[r][2 + h] = prow[1024 + h * 64 + lane]; } }
#pragma unroll
            for (int r = 0; r < 4; ++r) { const int row = row0 + r;
                const int t = row < SEQ0 ? row : ((row - SEQ0) & (SEQS - 1));
                unsigned* prow = (unsigned*)(proj + (size_t)row * INW);
                float sa0, ca0, sa1, ca1; sincos_ang((float)t * invA0, sa0, ca0); sincos_ang((float)t * invA1, sa1, ca1);
                sa0 *= sgnA; sa1 *= sgnA;
#pragma unroll
                for (int h = 0; h < 2; ++h) { const unsigned w = wq[r][h]; const unsigned pw = (unsigned)__shfl_xor((int)w, 32);
                    const float y0 = bflo(w) * ca0 + bflo(pw) * sa0, y1 = bfhi(w) * ca1 + bfhi(pw) * sa1;
                    prow[512 + h * 64 + lane] = pk2(y0, y1); }
                const float posB = (float)((lane & 32) ? (t & 63) : (t >> 6));
                float sb0, cb0, sb1, cb1; sincos_ang(posB * invB0, sb0, cb0); sincos_ang(posB * invB1, sb1, cb1);
                sb0 *= sgnB; sb1 *= sgnB;
#pragma unroll
                for (int h = 0; h < 2; ++h) { const unsigned w = wq[r][2 + h]; float x0 = bflo(w), x1 = bfhi(w);
                    const float ssq = wave_sum(x0 * x0 + x1 * x1); const float rr = 1.0f / sqrtf(ssq * (1.0f / 128.0f) + EPS);
                    x0 *= rr * kg0; x1 *= rr * kg1;
                    const float p0 = __shfl_xor(x0, 16), p1 = __shfl_xor(x1, 16);
                    prow[1024 + h * 64 + lane] = pk2(x0 * cb0 + p0 * sb0, x1 * cb1 + p1 * sb1); }
            }
        }
    }
    SEAM(2);

    if (IN(3)) {
        const att::bf16* pj = (const att::bf16*)proj; const att::bf16* kv = (const att::bf16*)kvm;
        if (ATT_MASK & 1) for (int ub = cu; ub < 512; ub += G) {
            const int v = ub & 255, xcd = v & 7, idx = v >> 3; int head, row0, srow, slen;
            if (ub < 256) { head = xcd >> 1; row0 = ((xcd & 1) * 32 + idx) * 256; srow = 0; slen = SEQ0; }
            else { const int b = xcd >> 2; head = xcd & 3; srow = SEQ0 + b * SEQS; slen = SEQS; row0 = srow + idx * 256; }
            const int kvh = head >> 1;
            att::attn_body<0, 2>(pj + (size_t)row0 * INW + 1536 + head * 128, pj + (size_t)srow * INW + 2048 + kvh * 128, pj + (size_t)srow * INW + 2304 + kvh * 128,
                                 Obuf + (size_t)row0 * DM + 1024 + head * 128, hs + (size_t)row0 * 16 + 8 + head, slen, INW, 0, nullptr, row0 - srow, P.in[9], (char*)lds);
        }
        if (ATT_MASK & 2) for (int ua = cu; ua < 1024; ua += G) {
            const int hp = ua & 3, row0 = (ua >> 2) * 128, h0 = hp * 2, kvh = hp >> 1;
            const int srow = row0 < SEQ0 ? 0 : SEQ0 + ((row0 - SEQ0) / SEQS) * SEQS, send = row0 < SEQ0 ? SEQ0 : srow + SEQS;
            const int ks = max(row0 - 128, srow), ke = min(row0 + 256, send);
            att::attn_body<1, 1>(pj + (size_t)row0 * INW + h0 * 128, pj + (size_t)ks * INW + 1024 + kvh * 128, pj + (size_t)ks * INW + 1280 + kvh * 128,
                                 Obuf + (size_t)row0 * DM + h0 * 128, hs + (size_t)row0 * 16 + h0, ke - ks, INW, row0 - ks, P.in[8] + h0, row0 - srow, nullptr, (char*)lds);
        }
        if (ATT_MASK & 4) for (int um = cu; um < 512; um += G) {
            const int head = um & 3, qb = um >> 2, row0 = qb * 256; const int sq = row0 < SEQ0 ? 0 : 1 + (row0 - SEQ0) / SEQS;
            att::attn_body<0, 0>(pj + (size_t)row0 * INW + 2560 + head * 128, kv + (size_t)sq * 256 * MKV + head * 128, kv + (size_t)sq * 256 * MKV + 512 + head * 128,
                                 Obuf + (size_t)row0 * DM + 1536 + head * 128, hs + (size_t)row0 * 16 + 12 + head, 256, MKV, 0, nullptr, 0, nullptr, (char*)lds);
        }
    }
    SEAM(3);

    SEAM(4);

    if (IN(5)) {
        pg8::Gemm g{Obuf, WoutT, MTOK, DM, DM}; pg8::StaticOrder S; S.init(MTOK, DM, G, cu);
        LAS float* tab = (LAS float*)((LAS unsigned char*)lds + 131072);
        {
            pg8::Unit u;
            for (int ui = 0; ui < 4 && S.next(ui, u); ++ui) if (tid < 256) {
                const f32x4* hp = (const f32x4*)(hs + (size_t)(u.pm * 256 + tid) * 16);
                const f32x4 a0 = hp[0], a1 = hp[1], b0 = hp[2], m0 = hp[3];
                const float sA = ((a0[0] + a0[1]) + (a0[2] + a0[3])) + ((a1[0] + a1[1]) + (a1[2] + a1[3])), sB = (b0[0] + b0[1]) + (b0[2] + b0[3]), sM = (m0[0] + m0[1]) + (m0[2] + m0[3]);
                const float rA = 1.0f / sqrtf(sA * (1.0f / 1024.0f) + EPS), rB = 1.0f / sqrtf(sB * (1.0f / 512.0f) + EPS), rM = 1.0f / sqrtf(sM * (1.0f / 512.0f) + EPS);
                f32x4 t4; t4[0] = rA / rB; t4[1] = rB / rM; t4[2] = rM; t4[3] = 0.f;
                *(LAS f32x4*)(tab + (ui * 256 + tid) * 4) = t4;
            }
            __syncthreads();
        }
        pg8::EpiResidX E{x_prompt, x_sample, x1b, ss2, (const LAS float*)tab};
        pg8::gemm_phase<pg8::EpiResidX, pg8::StaticOrder, true, true, true>((LAS unsigned char*)lds, g, S, E);
    }
    SEAM(5);

#pragma unroll
    for (int half = 0; half < 2; ++half) {
        const int rb = half * 16384;
        if (IN(6 + 2 * half)) {
            pg8::Gemm g{x1b + (size_t)rb * DM, WguT, 16384, NGU, DM}; pg8::StaticOrder S; S.init(16384, NGU, G, cu);
            pg8::EpiSwiglu E{act, ss2, rb};
            pg8::gemm_phase<pg8::EpiSwiglu, pg8::StaticOrder, true, true>((LAS unsigned char*)lds, g, S, E);
        }
        SEAM(6 + 2 * half);
        if (IN(7 + 2 * half)) {
            pg8::Gemm g{act, WdT, 16384, DM, DFF}; pg8::StaticOrder S; S.init(16384, DM, G, cu);
            pg8::EpiResidB E{x1b, ss3, rb};
            pg8::gemm_phase<pg8::EpiResidB, pg8::StaticOrder, true, true>((LAS unsigned char*)lds, g, S, E);
        }
        SEAM(7 + 2 * half);
    }

    if (IN(10)) {
        int tidf_ = threadIdx.x; asm volatile("" : "+v"(tidf_)); const int lane = tidf_ & 63, wave = __builtin_amdgcn_readfirstlane(tidf_ >> 6), gw = cu * NWAVES + wave; (void)lane; (void)gw;
        const f32x4* gf = (const f32x4*)P.in[16] + lane; f32x4 gv[8];
#pragma unroll
        for (int j = 0; j < 8; ++j) gv[j] = gf[64 * j];
        for (int row0 = gw * 4; row0 < MTOK; row0 += NGW * 4) {
            v2u y[4][8]; float rs[4];
#pragma unroll
            for (int r = 0; r < 4; ++r) { rs[r] = ss3[row0 + r];
#pragma unroll
                for (int j = 0; j < 8; ++j) y[r][j] = __builtin_nontemporal_load((const v2u*)(x1b + (size_t)(row0 + r) * DM) + lane + 64 * j); }
#pragma unroll
            for (int r = 0; r < 4; ++r) { const float q = 1.0f / sqrtf(rs[r] * (1.0f / 2048.0f) + EPS);
                f32x4* op = (f32x4*)(P.out + (size_t)(row0 + r) * DM) + lane;
#pragma unroll
                for (int j = 0; j < 8; ++j) { f32x4 v; v.x = bflo(y[r][j].x); v.y = bfhi(y[r][j].x); v.z = bflo(y[r][j].y); v.w = bfhi(y[r][j].y); __builtin_nontemporal_store(v * q * gv[j], op + 64 * j); } }
        }
    }
#undef IN
#undef SEAM
}

constexpr int NPH = 11;
#ifndef N_SPLIT
#define N_SPLIT 0
#endif
extern "C" void kernel_launch(void* const* d_in, const int* in_sizes, int n_in, void* d_out, int out_size, void* d_ws, size_t ws_size, hipStream_t stream) {
    static int grid = 0;
    if (grid == 0) {
        if (n_in != 17 || out_size != MTOK * DM || ws_size < WS_END) { fprintf(stderr, "kernel_launch: unexpected shapes n_in %d out %d ws %zu\n", n_in, out_size, ws_size); grid = -1; return; }
        int dev = 0, cus = 0, per_cu = 0;
        (void)hipGetDevice(&dev); (void)hipDeviceGetAttribute(&cus, hipDeviceAttributeMultiprocessorCount, dev);
        if (hipFuncSetAttribute((const void*)hymba_fwd, hipFuncAttributeMaxDynamicSharedMemorySize, LDS_BYTES) != hipSuccess) { fprintf(stderr, "kernel_launch: hipFuncSetAttribute failed\n"); grid = -1; return; }
        (void)hipOccupancyMaxActiveBlocksPerMultiprocessor(&per_cu, (const void*)hymba_fwd, NWAVES * 64, LDS_BYTES);
        if (per_cu < 1) { fprintf(stderr, "kernel_launch: occupancy query says %d blocks per CU\n", per_cu); per_cu = 1; }
        (void)hipGetLastError();
        grid = cus;
    }
    if (grid < 0) return;
    Params p{};
    for (int i = 0; i < 17; ++i) p.in[i] = (const float*)d_in[i];
    p.out = (float*)d_out; p.ws = (unsigned char*)d_ws;
#if N_SPLIT
    for (int k = 0; k < NPH; ++k) { p.ph_lo = k; p.ph_hi = k + 1; hipLaunchKernelGGL(hymba_fwd, dim3(grid), dim3(NWAVES * 64), LDS_BYTES, stream, p); }
#else
    void* args[] = {&p};
#ifdef PROBE_REPEAT
    p.ph_lo = 0; p.ph_hi = PROBE_REPEAT + 1;
    (void)hipLaunchCooperativeKernel((const void*)hymba_fwd, dim3(grid), dim3(NWAVES * 64), args, LDS_BYTES, stream);
    p.ph_lo = PROBE_REPEAT; p.ph_hi = NPH;
    (void)hipLaunchCooperativeKernel((const void*)hymba_fwd, dim3(grid), dim3(NWAVES * 64), args, LDS_BYTES, stream);
#else
    p.ph_lo = 0; p.ph_hi = NPH;
    hipError_t e = hipLaunchCooperativeKernel((const void*)hymba_fwd, dim3(grid), dim3(NWAVES * 64), args, LDS_BYTES, stream);
    if (e != hipSuccess) fprintf(stderr, "cooperative launch failed: %s (grid %d)\n", hipGetErrorString(e), grid);
#endif
#endif
}
```

```cpp
#include <hip/hip_runtime.h>
#include <hip/hip_cooperative_groups.h>
#include <hip/hip_bf16.h>
#include <cstdio>
#include <cstdint>
#include <cmath>
namespace cg = cooperative_groups;
namespace pg8 {
#define PG8_LAS __attribute__((address_space(3)))
typedef unsigned short bf16_t;
typedef short bf16x8 __attribute__((ext_vector_type(8)));
typedef float f32x4 __attribute__((ext_vector_type(4)));
typedef unsigned u32x4 __attribute__((ext_vector_type(4)));
constexpr int BM = 256, BK = 64, HALF = 128, HTB = HALF * BK * 2  , STAGE_BYTES = 8 * HTB, NXCD = 8, WGM = 8;

__host__ __device__ __forceinline__ int lds_byte(int r, int c) { const int st = (r >> 4) * 2 + (c >> 5), rr = r & 15, cc = c & 31, ob = rr * 64 + cc * 2; return st * 1024 + (ob ^ (((ob >> 9) & 1) << 5)); }
__host__ __device__ __forceinline__ void stage_rc(int b, int& R, int& C) { const int st = b / 1024, sb = b % 1024, swz = sb ^ (((sb >> 9) & 1) << 5); R = (st >> 1) * 16 + swz / 64; C = (st & 1) * 32 + (swz % 64) / 2; }
__host__ __device__ __forceinline__ int perm32(int rho) { const int n = rho >> 4, i = rho & 15; return 8 * (i >> 2) + 4 * n + (i & 3); }

struct Unit { int pm, pn; };
struct Gemm { const bf16_t* A; const bf16_t* Bt; int M, N, K; };

struct StaticOrder {
    int nM, nN, nwg, G, c;
    __host__ __device__ void init(int M, int N, int G_, int c_) { nM = M / BM; nN = N / BM; nwg = nM * nN; G = G_; c = c_; }
    __host__ __device__ bool next(int i, Unit& u) const {
        const long L = (long)i * G + c; if (L >= nwg) return false;
        int wgid = (int)L; { const int q = nwg / NXCD, r = nwg % NXCD, xcd = wgid % NXCD, off = wgid / NXCD; wgid = (xcd < r ? xcd * (q + 1) : r * (q + 1) + (xcd - r) * q) + off; }
        const int nig = WGM * nN, gid = wgid / nig, fm = gid * WGM, gsz = (nM - fm) < WGM ? (nM - fm) : WGM;
        u.pm = fm + ((wgid % nig) % gsz); u.pn = (wgid % nig) / gsz; return true;
    }
    __device__ __forceinline__ void a_ready(const Unit&) const {}
    __device__ __forceinline__ void done(const Unit&) const {}
};

__device__ __forceinline__ unsigned cvt_pk_bf16(float lo, float hi) { unsigned r; asm volatile("v_cvt_pk_bf16_f32 %0, %1, %2" : "=v"(r) : "v"(lo), "v"(hi)); return r; }
typedef float f32x2 __attribute__((ext_vector_type(2)));
template <class Epi, class Sched, bool ALIGN_EPI = false, bool SP2 = false, bool KSEG = false>
__device__ __forceinline__ void gemm_phase(PG8_LAS unsigned char* lds, const Gemm g, const Sched& S, const Epi& E) {
    const int tid = threadIdx.x, wid = __builtin_amdgcn_readfirstlane(tid >> 6), lane = tid & 63, wr = wid >> 2, wc = wid & 3, fr = lane & 15, fq = lane >> 4;
    const int K = g.K, nt = K / BK;
    unsigned voffA[2], voffB[2];
#pragma unroll
    for (int i = 0; i < 2; ++i) { int R, C; stage_rc(tid * 16 + i * 8192, R, C); const int Rb = Epi::PERM ? ((R & ~31) + perm32(R & 31)) : R;
        voffA[i] = (unsigned)(R * K + C) * 2u; voffB[i] = (unsigned)(Rb * K + C) * 2u; }
    const size_t kstep = (size_t)(BK * 2);
    const size_t hstep = (size_t)HALF * K * 2;
    const size_t tstep = 2 * hstep;
    const unsigned ldsw = (unsigned)wid * 1024u;
    const int aoff = lds_byte(wr * 64 + fr, fq * 8), boff = lds_byte(wc * 32 + fr, fq * 8);
#define PG8_SA(b, h) (((b) * 2 + (h)) * HTB)
#define PG8_SB(b, h) ((4 + (b) * 2 + (h)) * HTB)
#define PG8_STAGE(bufoff, gbase, voff) do { _Pragma("unroll") for (int _i = 0; _i < 2; ++_i) \
        __builtin_amdgcn_global_load_lds((const unsigned*)((const char*)(gbase) + (voff)[_i]), (PG8_LAS unsigned*)(lds + (bufoff) + ldsw + _i * 8192), 16, 0, 0); } while (0)
#define PG8_LDA(dst, b, h) do { _Pragma("unroll") for (int m = 0; m < 4; ++m) _Pragma("unroll") for (int k = 0; k < 2; ++k) dst[m][k] = *(const PG8_LAS bf16x8*)(lds + PG8_SA(b, h) + aoff + m * 2048 + k * 1024); } while (0)
#define PG8_LDB(dst, b, h) do { _Pragma("unroll") for (int n = 0; n < 2; ++n) _Pragma("unroll") for (int k = 0; k < 2; ++k) dst[n][k] = *(const PG8_LAS bf16x8*)(lds + PG8_SB(b, h) + boff + n * 2048 + k * 1024); } while (0)
#define PG8_MMA(ai, bj, At, Bt) do { __builtin_amdgcn_s_setprio(1); _Pragma("unroll") for (int m = 0; m < 4; ++m) _Pragma("unroll") for (int n = 0; n < 2; ++n) _Pragma("unroll") for (int k = 0; k < 2; ++k) \
        acc[ai][bj][m][n] = __builtin_amdgcn_mfma_f32_16x16x32_bf16(Bt[n][k], At[m][k], acc[ai][bj][m][n], 0, 0, 0); __builtin_amdgcn_s_setprio(0); } while (0)
#define PG8_WAIT_V(n) asm volatile("s_waitcnt vmcnt(" #n ")" ::: "memory")
#define PG8_WAIT_L(n) asm volatile("s_waitcnt lgkmcnt(" #n ")" ::: "memory")
#define PG8_BAR __builtin_amdgcn_s_barrier()
#define PG8_SCHED __builtin_amdgcn_sched_barrier(0)
    Unit cur, nxt; int ui = 0;
    if (!S.next(0, cur)) return;
    f32x4 acc[2][2][4][2];
#pragma unroll
    for (int a = 0; a < 2; ++a)
#pragma unroll
        for (int b = 0; b < 2; ++b)
#pragma unroll
            for (int m = 0; m < 4; ++m)
#pragma unroll
                for (int n = 0; n < 2; ++n) acc[a][b][m][n] = (f32x4){0.f, 0.f, 0.f, 0.f};
    bf16x8 At[4][2], B0[2][2], B1[2][2];
    const char* cA = (const char*)g.A + (size_t)cur.pm * tstep; const char* cB = (const char*)g.Bt + (size_t)cur.pn * tstep;
    S.a_ready(cur);
    if constexpr (SP2) {
        PG8_STAGE(PG8_SB(0, 0), cB, voffB); PG8_STAGE(PG8_SB(0, 1), cB + hstep, voffB); PG8_STAGE(PG8_SA(0, 0), cA, voffA); PG8_STAGE(PG8_SA(0, 1), cA + hstep, voffA);
        if (wr == 1) PG8_BAR;
        PG8_WAIT_V(2); PG8_BAR;
        PG8_STAGE(PG8_SB(1, 0), cB + kstep, voffB); PG8_STAGE(PG8_SA(1, 0), cA + kstep, voffA); PG8_STAGE(PG8_SB(1, 1), cB + hstep + kstep, voffB);
        PG8_WAIT_V(6); PG8_BAR;
    } else {
        PG8_STAGE(PG8_SB(0, 0), cB, voffB); PG8_STAGE(PG8_SA(0, 0), cA, voffA); PG8_STAGE(PG8_SB(0, 1), cB + hstep, voffB); PG8_STAGE(PG8_SA(0, 1), cA + hstep, voffA);
        if (wr == 1) PG8_BAR;
        PG8_WAIT_V(4); PG8_BAR;
        PG8_STAGE(PG8_SB(1, 0), cB + kstep, voffB); PG8_STAGE(PG8_SA(1, 0), cA + kstep, voffA); PG8_STAGE(PG8_SB(1, 1), cB + hstep + kstep, voffB);
        PG8_WAIT_V(6); PG8_BAR;
    }
    for (;;) {
        const bool has_next = S.next(ui + 1, nxt);
        const char* nA = has_next ? (const char*)g.A + (size_t)nxt.pm * tstep : cA; const char* nB = has_next ? (const char*)g.Bt + (size_t)nxt.pn * tstep : cB;
        for (int t = 0; t < nt; t += 2) {
            const bool last = (t == nt - 2);
            const char* a1 = cA + (size_t)(t + 1) * kstep;
            const char* a2 = last ? nA : cA + (size_t)(t + 2) * kstep; const char* b2 = last ? nB : cB + (size_t)(t + 2) * kstep;
            const char* a3 = a2 + kstep; const char* b3 = b2 + kstep;
            if (last && has_next) S.a_ready(nxt);
            if constexpr (SP2) {
            PG8_LDB(B0, 0, 0); PG8_LDB(B1, 0, 1); PG8_SCHED; PG8_LDA(At, 0, 0); PG8_STAGE(PG8_SA(1, 1), a1 + hstep, voffA);
            PG8_WAIT_V(8); PG8_WAIT_L(0); PG8_BAR; PG8_MMA(0, 0, At, B0); PG8_MMA(0, 1, At, B1); PG8_BAR; PG8_SCHED;
            PG8_LDA(At, 0, 1); PG8_STAGE(PG8_SB(0, 0), b2, voffB); PG8_STAGE(PG8_SB(0, 1), b2 + hstep, voffB); PG8_STAGE(PG8_SA(0, 0), a2, voffA);
            PG8_WAIT_V(8); PG8_WAIT_L(0); PG8_BAR; PG8_MMA(1, 0, At, B0); PG8_MMA(1, 1, At, B1); PG8_BAR; PG8_SCHED;
            PG8_LDB(B0, 1, 0); PG8_LDB(B1, 1, 1); PG8_SCHED; PG8_LDA(At, 1, 0); PG8_STAGE(PG8_SA(0, 1), a2 + hstep, voffA);
            PG8_WAIT_V(8); PG8_WAIT_L(0); PG8_BAR; PG8_MMA(0, 0, At, B0); PG8_MMA(0, 1, At, B1); PG8_BAR; PG8_SCHED;
            PG8_LDA(At, 1, 1); PG8_STAGE(PG8_SB(1, 0), b3, voffB); PG8_STAGE(PG8_SB(1, 1), b3 + hstep, voffB); PG8_STAGE(PG8_SA(1, 0), a3, voffA);
            PG8_WAIT_V(8); PG8_WAIT_L(0); PG8_BAR; PG8_MMA(1, 0, At, B0); PG8_MMA(1, 1, At, B1); PG8_BAR; PG8_SCHED;
            } else {
            PG8_LDB(B0, 0, 0); PG8_SCHED; PG8_LDA(At, 0, 0); PG8_STAGE(PG8_SA(1, 1), a1 + hstep, voffA);
            PG8_WAIT_L(8); PG8_BAR; PG8_WAIT_L(0); PG8_MMA(0, 0, At, B0); PG8_BAR; PG8_SCHED;
            PG8_LDB(B1, 0, 1); PG8_STAGE(PG8_SB(0, 0), b2, voffB);
            PG8_BAR; PG8_WAIT_L(0); PG8_MMA(0, 1, At, B1); PG8_BAR;
            PG8_LDA(At, 0, 1); PG8_STAGE(PG8_SA(0, 0), a2, voffA);
            PG8_BAR; PG8_WAIT_L(0); PG8_MMA(1, 0, At, B0); PG8_BAR; PG8_SCHED;
            PG8_STAGE(PG8_SB(0, 1), b2 + hstep, voffB);
            PG8_WAIT_V(6); PG8_BAR; PG8_MMA(1, 1, At, B1); PG8_BAR;
            PG8_LDB(B0, 1, 0); PG8_SCHED; PG8_LDA(At, 1, 0); PG8_STAGE(PG8_SA(0, 1), a2 + hstep, voffA);
            PG8_WAIT_L(8); PG8_BAR; PG8_WAIT_L(0); PG8_MMA(0, 0, At, B0); PG8_BAR; PG8_SCHED;
            PG8_LDB(B1, 1, 1); PG8_STAGE(PG8_SB(1, 0), b3, voffB);
            PG8_BAR; PG8_WAIT_L(0); PG8_MMA(0, 1, At, B1); PG8_BAR;
            PG8_LDA(At, 1, 1); PG8_STAGE(PG8_SA(1, 0), a3, voffA);
            PG8_BAR; PG8_WAIT_L(0); PG8_MMA(1, 0, At, B0); PG8_BAR; PG8_SCHED;
            PG8_STAGE(PG8_SB(1, 1), b3 + hstep, voffB);
            PG8_WAIT_V(6); PG8_BAR; PG8_MMA(1, 1, At, B1); PG8_BAR;
            }
            if constexpr (KSEG) { if (t == 14 || t == 22) E.kscale(acc, ui, t == 14 ? 0 : 1, wr, fr); }
        }
        if constexpr (ALIGN_EPI) { if (wr == 0) PG8_BAR; }
        if constexpr (!Epi::AFTER_DRAIN) { if constexpr (KSEG) E.final(acc, cur, ui, wr, wc, fr, fq); else E(acc, cur, wr, wc, fr, fq); S.done(cur); }
        if (!has_next) break;
#pragma unroll
        for (int a = 0; a < 2; ++a)
#pragma unroll
            for (int b = 0; b < 2; ++b)
#pragma unroll
                for (int m = 0; m < 4; ++m)
#pragma unroll
                    for (int n = 0; n < 2; ++n) acc[a][b][m][n] = (f32x4){0.f, 0.f, 0.f, 0.f};
        cur = nxt; cA = nA; cB = nB; ++ui;
        if constexpr (ALIGN_EPI) { if (wr == 1) PG8_BAR; }
    }
    PG8_WAIT_V(0);
    if constexpr (!ALIGN_EPI) { if (wr == 0) PG8_BAR; }
    PG8_BAR;
    if constexpr (Epi::AFTER_DRAIN) { E.fused(acc, cur, wr, wc, fr, fq, lds, wid, lane); S.done(cur); }
#undef PG8_SA
#undef PG8_SB
#undef PG8_STAGE
#undef PG8_LDA
#undef PG8_LDB
#undef PG8_MMA
#undef PG8_WAIT_V
#undef PG8_WAIT_L
#undef PG8_BAR
#undef PG8_SCHED
}
}
namespace att {
using bf16 = __hip_bfloat16;
constexpr int   D = 128, NW = 8, QBLK = 32, KVBLK = 64;
constexpr float SCALE = 0.088388347648318440f;
constexpr float THR = 8.f;
constexpr size_t SHM_V = KVBLK * D * 2, SHM_K = KVBLK * D * 2, SHM_ATTN = 2 * SHM_V + 2 * SHM_K + NW * 64 * 4;
using bf16x8 = __attribute__((ext_vector_type(8))) short;
using s16x4  = __attribute__((ext_vector_type(4))) short;
using f32x16 = __attribute__((ext_vector_type(16))) float;
using f32x8  = __attribute__((ext_vector_type(8))) float;
using u32x4  = __attribute__((ext_vector_type(4))) unsigned;
#define KSWZ(row, colB) ((row) * 256 + ((colB) ^ (((row) & 7) << 4)))
#define SBAR() __builtin_amdgcn_sched_barrier(0)
__device__ __forceinline__ int crow(int r, int hi) { return (r & 3) + 8 * (r >> 2) + 4 * hi; }
__device__ __forceinline__ unsigned cvtpk(float lo, float hi) {
  unsigned r; asm volatile("v_cvt_pk_bf16_f32 %0, %1, %2" : "=v"(r) : "v"(lo), "v"(hi)); return r;
}
template <typename TIn> struct Stage;
template <> struct Stage<bf16>  { using T = bf16x8;
  __device__ static __forceinline__ T ld8(const bf16* p) { return *reinterpret_cast<const bf16x8*>(p); }
  __device__ static __forceinline__ bf16x8 tobf(T x) { return x; } };
template <> struct Stage<float> { using T = f32x8;
  __device__ static __forceinline__ T ld8(const float* p) { return *reinterpret_cast<const f32x8*>(p); }
  __device__ static __forceinline__ bf16x8 tobf(T x) {
    u32x4 w = {cvtpk(x[0], x[1]), cvtpk(x[2], x[3]), cvtpk(x[4], x[5]), cvtpk(x[6], x[7])}; return *reinterpret_cast<bf16x8*>(&w); } };

__device__ __forceinline__ void partialSM(f32x16& p0, f32x16& p1, float& m_reg, float& mn, float& alpha) {
  constexpr float C = SCALE * 1.4426950408889634f;
  float pmax = p0[0]; for (int r = 1; r < 16; ++r) pmax = fmaxf(pmax, p0[r]); for (int r = 0; r < 16; ++r) pmax = fmaxf(pmax, p1[r]);
  { auto rr = __builtin_amdgcn_permlane32_swap(__float_as_uint(pmax), __float_as_uint(pmax), false, false);
    pmax = fmaxf(__uint_as_float(rr[0]), __uint_as_float(rr[1])); }
  if (__builtin_expect(__all(pmax - m_reg <= THR / SCALE), 1)) { mn = m_reg; alpha = 1.f; }
  else { mn = fmaxf(m_reg, pmax); alpha = __builtin_amdgcn_exp2f((m_reg - mn) * C); m_reg = mn; }
  float mnC = -mn * C;
  for (int r = 0; r < 16; ++r) p0[r] = fmaf(p0[r], C, mnC); for (int r = 0; r < 16; ++r) p1[r] = fmaf(p1[r], C, mnC);
  for (int r = 0; r < 16; ++r) p0[r] = __builtin_amdgcn_exp2f(p0[r]);
}
__device__ __forceinline__ float psm_max0(const f32x16& p0) { float a = p0[0]; for (int r = 1; r < 16; ++r) a = fmaxf(a, p0[r]); return a; }
__device__ __forceinline__ void psm_decide(float pmax, const f32x16& p1, float& m_reg, float& mn, float& alpha) {
  constexpr float C = SCALE * 1.4426950408889634f;
  for (int r = 0; r < 16; ++r) pmax = fmaxf(pmax, p1[r]);
  { auto rr = __builtin_amdgcn_permlane32_swap(__float_as_uint(pmax), __float_as_uint(pmax), false, false);
    pmax = fmaxf(__uint_as_float(rr[0]), __uint_as_float(rr[1])); }
  if (__builtin_expect(__all(pmax - m_reg <= THR / SCALE), 1)) { mn = m_reg; alpha = 1.f; }
  else { mn = fmaxf(m_reg, pmax); alpha = __builtin_amdgcn_exp2f((m_reg - mn) * C); m_reg = mn; }
}
__device__ __forceinline__ void psm_scale(f32x16& p0, f32x16& p1, float mn) {
  constexpr float C = SCALE * 1.4426950408889634f; const float mnC = -mn * C;
  for (int r = 0; r < 16; ++r) p0[r] = fmaf(p0[r], C, mnC); for (int r = 0; r < 16; ++r) p1[r] = fmaf(p1[r], C, mnC);
}
__device__ __forceinline__ void psm_exp0(f32x16& p0) { for (int r = 0; r < 16; ++r) p0[r] = __builtin_amdgcn_exp2f(p0[r]); }
__device__ __forceinline__ void finishSM(f32x16& p0, f32x16& p1, float alpha, float& l_reg, bf16x8& pa0, bf16x8& pa1, bf16x8& pa2, bf16x8& pa3) {
  for (int r = 0; r < 16; ++r) p1[r] = __builtin_amdgcn_exp2f(p1[r]);
  float ps = 0; for (int r = 0; r < 16; ++r) ps += p0[r]; for (int r = 0; r < 16; ++r) ps += p1[r];
  { auto rr = __builtin_amdgcn_permlane32_swap(__float_as_uint(ps), __float_as_uint(ps), false, false);
    ps = __uint_as_float(rr[0]) + __uint_as_float(rr[1]); }
  l_reg = l_reg * alpha + ps;
#define PK4(P, BASE, OUT) do { unsigned a0 = cvtpk(P[BASE + 0], P[BASE + 1]), a1 = cvtpk(P[BASE + 2], P[BASE + 3]);   \
    unsigned b0 = cvtpk(P[BASE + 4], P[BASE + 5]), b1 = cvtpk(P[BASE + 6], P[BASE + 7]);                              \
    auto r0 = __builtin_amdgcn_permlane32_swap(a0, b0, false, false); auto r1 = __builtin_amdgcn_permlane32_swap(a1, b1, false, false); \
    u32x4 w = {r0[0], r1[0], r0[1], r1[1]}; OUT = *reinterpret_cast<bf16x8*>(&w); } while (0)
  PK4(p0, 0, pa0); PK4(p0, 8, pa1); PK4(p1, 0, pa2); PK4(p1, 8, pa3);
#undef PK4
}
__device__ __forceinline__ void qkt(f32x16& p0, f32x16& p1, const bf16* Ks, const bf16x8* qr, int r32, int hi) {
  p0 = f32x16{}; p1 = f32x16{};
  for (int d0 = 0; d0 < 8; ++d0) { int cb = (d0 * 16 + hi * 8) * 2;
    bf16x8 b0 = *reinterpret_cast<const bf16x8*>((const char*)Ks + KSWZ(r32, cb));
    bf16x8 b1 = *reinterpret_cast<const bf16x8*>((const char*)Ks + KSWZ(32 + r32, cb));
    p0 = __builtin_amdgcn_mfma_f32_32x32x16_bf16(b0, qr[d0], p0, 0, 0, 0);
    p1 = __builtin_amdgcn_mfma_f32_32x32x16_bf16(b1, qr[d0], p1, 0, 0, 0); }
}
__device__ __forceinline__ int v_st(int k, int c) { const int kk = (k & ~0xC) | ((k & 4) << 1) | ((k & 8) >> 1); return ((kk >> 3) * 4 + (c >> 5)) * 512 + ((kk & 7) * 32 + (c & 31)) * 2; }
__device__ __forceinline__ int v_rd_base(int lane) { return ((lane & 3) << 3) | (((lane >> 2) & 3) << 6) | (((lane >> 4) & 1) << 5) | (((lane >> 5) & 1) << 8); }
constexpr int v_rd_off(int d0, int ks, int half) { return d0 * 512 + ks * 4096 + half * 2048; }
template <int OFF> __device__ __forceinline__ s16x4 tr_read(int vb) {
  s16x4 r; asm volatile("ds_read_b64_tr_b16 %0, %1 offset:%2" : "=&v"(r) : "v"(vb), "i"(OFF) : "memory"); return r;
}
template <int D0> __device__ __forceinline__ void pv_one(f32x16& od, int vb, bf16x8 pa0, bf16x8 pa1, bf16x8 pa2, bf16x8 pa3) {
  const s16x4 l0 = tr_read<v_rd_off(D0, 0, 0)>(vb), h0 = tr_read<v_rd_off(D0, 0, 1)>(vb), l1 = tr_read<v_rd_off(D0, 1, 0)>(vb), h1 = tr_read<v_rd_off(D0, 1, 1)>(vb);
  const s16x4 l2 = tr_read<v_rd_off(D0, 2, 0)>(vb), h2 = tr_read<v_rd_off(D0, 2, 1)>(vb), l3 = tr_read<v_rd_off(D0, 3, 0)>(vb), h3 = tr_read<v_rd_off(D0, 3, 1)>(vb);
  asm volatile("s_waitcnt lgkmcnt(0)" ::: "memory"); SBAR();
#define PK(L, H) (bf16x8){L[0], L[1], L[2], L[3], H[0], H[1], H[2], H[3]}
  od = __builtin_amdgcn_mfma_f32_32x32x16_bf16(pa0, PK(l0, h0), od, 0, 0, 0);
  od = __builtin_amdgcn_mfma_f32_32x32x16_bf16(pa1, PK(l1, h1), od, 0, 0, 0);
  od = __builtin_amdgcn_mfma_f32_32x32x16_bf16(pa2, PK(l2, h2), od, 0, 0, 0);
  od = __builtin_amdgcn_mfma_f32_32x32x16_bf16(pa3, PK(l3, h3), od, 0, 0, 0);
#undef PK
}
__device__ __forceinline__ void pv_d0(f32x16* o, int vb, bf16x8 pa0, bf16x8 pa1, bf16x8 pa2, bf16x8 pa3) {
  pv_one<0>(o[0], vb, pa0, pa1, pa2, pa3); pv_one<1>(o[1], vb, pa0, pa1, pa2, pa3); pv_one<2>(o[2], vb, pa0, pa1, pa2, pa3); pv_one<3>(o[3], vb, pa0, pa1, pa2, pa3);
}
__device__ __forceinline__ void maskwin(f32x16& p0, f32x16& p1, int mb) {
#pragma unroll
  for (int r = 0; r < 16; ++r) { const int dk = mb + (r & 3) + 8 * (r >> 2);
    if ((unsigned)dk > 256u) p0[r] = -INFINITY; if ((unsigned)(dk + 32) > 256u) p1[r] = -INFINITY; }
}
constexpr int LDQ = 3072, LDO = 2048;
using f32x4 = __attribute__((ext_vector_type(4))) float;
__device__ __forceinline__ float bf2f(short v) { return __builtin_bit_cast(float, ((unsigned)(unsigned short)v) << 16); }
__device__ __forceinline__ void sincos_fast(float ang, float& sn, float& cs) { const float f = __builtin_amdgcn_fractf(ang * 0.15915494309189535f); sn = __builtin_amdgcn_sinf(f); cs = __builtin_amdgcn_cosf(f); }
template <int MODE, int QMODE>
__device__ __forceinline__ void attn_body(const bf16* __restrict__ Qb, const bf16* __restrict__ Kh, const bf16* __restrict__ Vh,
                                          unsigned short* __restrict__ Ob, float* __restrict__ hsp, int seq, int ldk, int qrel, const float* __restrict__ sinkp, int t0, const float* __restrict__ qg, char* lds) {
  using St = Stage<bf16>;
  int tid = threadIdx.x; asm volatile("" : "+v"(tid));
  const int wid = __builtin_amdgcn_readfirstlane(tid >> 6), lane = tid & 63, r32 = lane & 31, hi = lane >> 5;
  const int wrow = MODE ? (wid & 3) * QBLK : wid * QBLK, wcol = MODE ? (wid >> 2) * D : 0;
  bf16* V_lds = (bf16*)lds; bf16* K_lds = (bf16*)(lds + 2 * SHM_V);
  float* ws = (float*)(lds + 2 * SHM_V + 2 * SHM_K) + wid * 64; float* li_l = ws; float* al_l = ws + 32;
  float m_reg = MODE ? sinkp[wid >> 2] * (1.0f / SCALE) : -1e30f, l_reg = MODE ? 1.f : 0.f; bf16x8 qr[8];
  const bf16* Qw = Qb + (long)(wrow + r32) * LDQ + wcol + hi * 8;
#pragma unroll
  for (int d0 = 0; d0 < 8; ++d0) qr[d0] = __builtin_nontemporal_load((const bf16x8*)(Qw + d0 * 16));
  if constexpr (QMODE != 0) {
    const int t = t0 + wrow + r32; constexpr float L2T = 13.287712379549449f;
    if constexpr (QMODE == 2) {
      float ssq = 0.f;
#pragma unroll
      for (int d0 = 0; d0 < 8; ++d0)
#pragma unroll
        for (int j = 0; j < 8; ++j) { const float x = bf2f(qr[d0][j]); ssq += x * x; }
      { auto rr = __builtin_amdgcn_permlane32_swap(__float_as_uint(ssq), __float_as_uint(ssq), false, false); ssq = __uint_as_float(rr[0]) + __uint_as_float(rr[1]); }
      const float rn = 1.0f / sqrtf(ssq * (1.0f / 128.0f) + 1e-6f);
      const float posr = (float)(t >> 6), posc = (float)(t & 63);
#pragma unroll
      for (int hf = 0; hf < 2; ++hf)
#pragma unroll
        for (int dd = 0; dd < 2; ++dd) { const int da = hf * 4 + dd, db = da + 2;
          const f32x4 ga0 = *(const f32x4*)(qg + da * 16 + hi * 8), ga1 = *(const f32x4*)(qg + da * 16 + hi * 8 + 4), gb0 = *(const f32x4*)(qg + db * 16 + hi * 8), gb1 = *(const f32x4*)(qg + db * 16 + hi * 8 + 4);
          float ya[8], yb[8];
#pragma unroll
          for (int j = 0; j < 8; ++j) { const int i = dd * 16 + hi * 8 + j; const float inv = __builtin_amdgcn_exp2f(-(float)i * (L2T / 32.0f));
            float sn, cs; sincos_fast((hf ? posc : posr) * inv, sn, cs);
            const float x1 = bf2f(qr[da][j]) * rn * (j < 4 ? ga0[j & 3] : ga1[j & 3]), x2 = bf2f(qr[db][j]) * rn * (j < 4 ? gb0[j & 3] : gb1[j & 3]);
            ya[j] = x1 * cs - x2 * sn; yb[j] = x2 * cs + x1 * sn; }
          u32x4 wa = {cvtpk(ya[0], ya[1]), cvtpk(ya[2], ya[3]), cvtpk(ya[4], ya[5]), cvtpk(ya[6], ya[7])}, wb = {cvtpk(yb[0], yb[1]), cvtpk(yb[2], yb[3]), cvtpk(yb[4], yb[5]), cvtpk(yb[6], yb[7])};
          qr[da] = *reinterpret_cast<bf16x8*>(&wa); qr[db] = *reinterpret_cast<bf16x8*>(&wb); SBAR(); }
    } else {
      const float pos = (float)t;
#pragma unroll
      for (int d0 = 0; d0 < 4; ++d0) { float ya[8], yb[8];
#pragma unroll
        for (int j = 0; j < 8; ++j) { const int i = d0 * 16 + hi * 8 + j; const float inv = __builtin_amdgcn_exp2f(-(float)i * (L2T / 64.0f));
          float sn, cs; sincos_fast(pos * inv, sn, cs);
          const float x1 = bf2f(qr[d0][j]), x2 = bf2f(qr[d0 + 4][j]);
          ya[j] = x1 * cs - x2 * sn; yb[j] = x2 * cs + x1 * sn; }
        u32x4 wa = {cvtpk(ya[0], ya[1]), cvtpk(ya[2], ya[3]), cvtpk(ya[4], ya[5]), cvtpk(ya[6], ya[7])}, wb = {cvtpk(yb[0], yb[1]), cvtpk(yb[2], yb[3]), cvtpk(yb[4], yb[5]), cvtpk(yb[6], yb[7])};
        qr[d0] = *reinterpret_cast<bf16x8*>(&wa); qr[d0 + 4] = *reinterpret_cast<bf16x8*>(&wb); SBAR(); }
    }
  }
#pragma unroll
  for (int d0 = 0; d0 < 8; ++d0) asm volatile("" : "+v"(qr[d0]));
  asm volatile("" ::: "memory"); SBAR();
  f32x16 o[4] = {};
  const int sr = tid >> 4, sc = (tid & 15) * 8, vst0 = v_st(sr, sc), vst1 = v_st(32 + sr, sc);
  const int vb0 = (int)(uintptr_t)V_lds + v_rd_base(lane);
  const unsigned toff = (unsigned)(sr * ldk + sc) * 2u; const long h32 = (long)ldk * 64;
  constexpr int SDEPTH = (MODE == 0 && QMODE == 2) ? 2 : 1;
  struct { typename St::T vs0, vs1, ks0, ks1; } sr_[SDEPTH];
#define SLOAD(i, k0) do { const long to_ = (long)(k0) * ldk * 2; const char* vt_ = (const char*)Vh + to_; const char* kt_ = (const char*)Kh + to_; \
    sr_[i].vs0 = *(const bf16x8*)(vt_ + toff); sr_[i].vs1 = *(const bf16x8*)(vt_ + h32 + toff); \
    sr_[i].ks0 = *(const bf16x8*)(kt_ + toff); sr_[i].ks1 = *(const bf16x8*)(kt_ + h32 + toff); } while (0)
#define SWRITE(b, i) do { *(bf16x8*)((char*)V_lds + (b) * SHM_V + vst0) = St::tobf(sr_[i].vs0);          \
    *(bf16x8*)((char*)V_lds + (b) * SHM_V + vst1) = St::tobf(sr_[i].vs1); int kc = sc * 2;               \
    *(bf16x8*)((char*)K_lds + (b) * SHM_K + KSWZ(sr, kc)) = St::tobf(sr_[i].ks0);                       \
    *(bf16x8*)((char*)K_lds + (b) * SHM_K + KSWZ(32 + sr, kc)) = St::tobf(sr_[i].ks1); } while (0)
#define SWAIT() do { if constexpr (SDEPTH == 2) asm volatile("s_waitcnt vmcnt(4)" ::: "memory"); else asm volatile("s_waitcnt vmcnt(0)" ::: "memory"); } while (0)
#define RESC(a) do { if (__any((a) < 1.f)) { if (hi == 0) al_l[r32] = (a); asm volatile("s_waitcnt lgkmcnt(0)" ::: "memory"); \
    for (int d = 0; d < 4; ++d) for (int r = 0; r < 16; ++r) o[d][r] *= al_l[crow(r, hi)]; } } while (0)
  const int qw0 = qrel + wrow;
#define MASK(P0, P1, k0) do { if constexpr (MODE == 1) { const int k0_ = (k0); \
    if ((k0_ + 63 - qw0 > 128) || (k0_ - (qw0 + 31) < -128)) maskwin(P0, P1, k0_ - (qw0 + r32) + 128 + 4 * hi); } } while (0)
#define PVSM(VB, P0, P1, K0, MN, AL) do { MASK(P0, P1, K0); float pm_; \
    pv_one<0>(o[0], VB, pa0, pa1, pa2, pa3); pm_ = psm_max0(P0); \
    pv_one<1>(o[1], VB, pa0, pa1, pa2, pa3); psm_decide(pm_, P1, m_reg, MN, AL); \
    pv_one<2>(o[2], VB, pa0, pa1, pa2, pa3); psm_scale(P0, P1, MN); asm volatile("" : "+v"(P0), "+v"(P1)); \
    pv_one<3>(o[3], VB, pa0, pa1, pa2, pa3); psm_exp0(P0); asm volatile("" : "+v"(P0)); SBAR(); } while (0)
  if (wid >= 4) __builtin_amdgcn_s_setprio(1);
  f32x16 pA0, pA1, pB0, pB1; float mnA, mnB, alA, alB; bf16x8 pa0, pa1, pa2, pa3; const int NT = seq / KVBLK;
  constexpr int SE = 0, SO = SDEPTH - 1;
  SLOAD(SE, 0); asm volatile("s_waitcnt vmcnt(0)" ::: "memory"); SWRITE(0, SE); __syncthreads();
  qkt(pA0, pA1, K_lds, qr, r32, hi); MASK(pA0, pA1, 0); partialSM(pA0, pA1, m_reg, mnA, alA);
  SLOAD(SO, KVBLK); if constexpr (SDEPTH == 2) { if (2 < NT) SLOAD(SE, 2 * KVBLK); }
  SWAIT(); SWRITE(1, SO); __syncthreads();
  for (int j = 1; j + 1 < NT; j += 2) {
    SBAR(); qkt(pB0, pB1, (bf16*)((char*)K_lds + SHM_K), qr, r32, hi);
    finishSM(pA0, pA1, alA, l_reg, pa0, pa1, pa2, pa3); SBAR();
    SLOAD(SO, (j + SDEPTH) * KVBLK); SBAR();
    PVSM(vb0, pB0, pB1, j * KVBLK, mnB, alB);
    __syncthreads(); SWAIT(); SWRITE(0, SE);
    RESC(alB); __syncthreads();
    SBAR(); qkt(pA0, pA1, K_lds, qr, r32, hi);
    finishSM(pB0, pB1, alB, l_reg, pa0, pa1, pa2, pa3); SBAR();
    if (SDEPTH == 1 || j + 3 < NT) SLOAD(SE, (j + 1 + SDEPTH) * KVBLK); SBAR();
    PVSM(vb0 + (int)SHM_V, pA0, pA1, (j + 1) * KVBLK, mnA, alA);
    __syncthreads(); SWAIT(); SWRITE(1, SO);
    RESC(alA); __syncthreads();
  }
  SBAR(); qkt(pB0, pB1, (bf16*)((char*)K_lds + SHM_K), qr, r32, hi);
  finishSM(pA0, pA1, alA, l_reg, pa0, pa1, pa2, pa3); SBAR();
  PVSM(vb0, pB0, pB1, (NT - 1) * KVBLK, mnB, alB);
  __syncthreads(); RESC(alB);
  finishSM(pB0, pB1, alB, l_reg, pa0, pa1, pa2, pa3); SBAR();
  pv_d0(o, vb0 + (int)SHM_V, pa0, pa1, pa2, pa3);
  __builtin_amdgcn_s_setprio(0);
  if (hi == 0) li_l[r32] = l_reg; asm volatile("s_waitcnt lgkmcnt(0)" ::: "memory");
  float rli[16];
#pragma unroll
  for (int r = 0; r < 16; ++r) rli[r] = __builtin_amdgcn_rcpf(li_l[crow(r, hi)]);
  unsigned zz_ = 0u; asm volatile("" : "+v"(zz_)); const int r32e = (int)__builtin_amdgcn_mbcnt_hi(~0u, __builtin_amdgcn_mbcnt_lo(~0u, zz_)) & 31;
  unsigned short* Ow = Ob + (long)wrow * LDO + wcol + r32e;
#pragma unroll
  for (int r = 0; r < 16; ++r) { int orow = crow(r, hi);
#pragma unroll
    for (int d0 = 0; d0 < 4; ++d0) { const float v = o[d0][r] * rli[r]; Ow[(long)orow * LDO + d0 * 32] = (unsigned short)(cvtpk(v, v) & 0xffffu); o[d0][r] = v * v; } }
  { float* hw = hsp + (long)wrow * 16 + (MODE ? (wid >> 2) : 0);
#pragma unroll
    for (int r = 0; r < 16; ++r) { float q = (o[0][r] + o[1][r]) + (o[2][r] + o[3][r]);
      q += __builtin_bit_cast(float, __builtin_amdgcn_update_dpp(0, __builtin_bit_cast(int, q), 0xB1, 0xF, 0xF, true));
      q += __builtin_bit_cast(float, __builtin_amdgcn_update_dpp(0, __builtin_bit_cast(int, q), 0x4E, 0xF, 0xF, true));
      q += __builtin_bit_cast(float, __builtin_amdgcn_update_dpp(0, __builtin_bit_cast(int, q), 0x141, 0xF, 0xF, true));
      q += __builtin_bit_cast(float, __builtin_amdgcn_update_dpp(0, __builtin_bit_cast(int, q), 0x140, 0xF, 0xF, true));
      { float q2 = q; asm volatile("" : "+v"(q2)); auto rr = __builtin_amdgcn_permlane16_swap(__float_as_uint(q), __float_as_uint(q2), false, false); const unsigned a_ = rr[0], b_ = rr[1]; q = __uint_as_float(a_) + __uint_as_float(b_); }
      if (r32e == r) hw[(long)crow(r, hi) * 16] = q; } }
  __syncthreads();
#undef SLOAD
#undef SWRITE
#undef SWAIT
#undef RESC
#undef MASK
#undef PVSM
}
#undef KSWZ
#undef SBAR
}
#define LAS __attribute__((address_space(3)))
typedef unsigned short bf16_t;
typedef unsigned v4u __attribute__((ext_vector_type(4)));
typedef unsigned v2u __attribute__((ext_vector_type(2)));
typedef float f32x4 __attribute__((ext_vector_type(4)));
constexpr int MTOK = 32768, DM = 2048, INW = 3072, DFF = 5632, NGU = 2 * DFF, MEMR = 768, MKV = 1024, NWAVES = 8;
constexpr int SEQ0 = 16384, SEQS = 8192;
constexpr float EPS = 1e-6f;
constexpr size_t MiB = 1u << 20;
constexpr size_t WS_RSTD1 = 0, WS_SS2 = 128 * 1024, WS_SS3 = 256 * 1024, WS_RSTDM = 384 * 1024;
constexpr size_t WS_WIN = 2 * MiB, WS_WMEM = 14 * MiB, WS_WOUT = 18 * MiB, WS_WGU = 26 * MiB, WS_WD = 70 * MiB;
constexpr size_t WS_KVM = 92 * MiB, WS_MEMB = 94 * MiB;
constexpr size_t WS_XB = 98 * MiB;
constexpr size_t WS_PROJ = 226 * MiB;
constexpr size_t WS_X1B = 290 * MiB;
constexpr size_t WS_HS = 418 * MiB;
constexpr size_t WS_END = 420 * MiB;
constexpr int LDS_BYTES = 147456;

__device__ __forceinline__ unsigned f2bf(float f) { unsigned u = __builtin_bit_cast(unsigned, f); return (u + 0x7fffu + ((u >> 16) & 1u)) >> 16; }
__device__ __forceinline__ unsigned pk2(float lo, float hi) { return pg8::cvt_pk_bf16(lo, hi); }
__device__ __forceinline__ float bflo(unsigned w) { return __builtin_bit_cast(float, w << 16); }
__device__ __forceinline__ float bfhi(unsigned w) { return __builtin_bit_cast(float, w & 0xffff0000u); }
__device__ __forceinline__ float wave_sum(float v) {
#pragma unroll
    for (int o = 1; o < 64; o <<= 1) v += __shfl_xor(v, o);
    return v;
}
template <int CTRL> __device__ __forceinline__ float dppf(float v) { return __builtin_bit_cast(float, __builtin_amdgcn_update_dpp(0, __builtin_bit_cast(int, v), CTRL, 0xF, 0xF, true)); }
__device__ __forceinline__ float sum_x16(float v) { float v2 = v; asm volatile("" : "+v"(v2));
    auto rr = __builtin_amdgcn_permlane16_swap(__builtin_bit_cast(unsigned, v), __builtin_bit_cast(unsigned, v2), false, false); const unsigned a_ = rr[0], b_ = rr[1]; return __uint_as_float(a_) + __uint_as_float(b_); }
__device__ __forceinline__ float sum_x32(float v) { float v2 = v; asm volatile("" : "+v"(v2));
    auto rr = __builtin_amdgcn_permlane32_swap(__builtin_bit_cast(unsigned, v), __builtin_bit_cast(unsigned, v2), false, false); const unsigned a_ = rr[0], b_ = rr[1]; return __uint_as_float(a_) + __uint_as_float(b_); }
__device__ __forceinline__ float wave_sum_dpp(float v) {
    v += dppf<0xB1>(v); v += dppf<0x4E>(v); v += dppf<0x141>(v); v += dppf<0x140>(v);
    return sum_x32(sum_x16(v));
}
#define LDS_WAIT() asm volatile("s_waitcnt lgkmcnt(0)" ::: "memory")

namespace pg8 {
struct EpiScaleBf16 {
    static constexpr bool PERM = true, AFTER_DRAIN = false;
    bf16_t* O; int ldc; const float* rs;
    __device__ __forceinline__ void operator()(const f32x4 (&acc)[2][2][4][2], const Unit& u, int wr, int wc, int fr, int fq) const {
        const int row0 = u.pm * BM + wr * 64 + fr, col0 = u.pn * BM + wc * 32 + 8 * fq;
#pragma unroll
        for (int ai = 0; ai < 2; ++ai)
#pragma unroll
            for (int m = 0; m < 4; ++m) { const int row = row0 + ai * HALF + m * 16; const float s = rs[row]; bf16_t* rowp = O + (size_t)row * ldc + col0;
#pragma unroll
                for (int bj = 0; bj < 2; ++bj) { const f32x4 v0 = acc[ai][bj][m][0] * s, v1 = acc[ai][bj][m][1] * s;
                    u32x4 w; w.x = cvt_pk_bf16(v0[0], v0[1]); w.y = cvt_pk_bf16(v0[2], v0[3]); w.z = cvt_pk_bf16(v1[0], v1[1]); w.w = cvt_pk_bf16(v1[2], v1[3]);
                    *(u32x4*)(rowp + bj * HALF) = w; } }
    }
};
struct EpiResidX {
    static constexpr bool PERM = true, AFTER_DRAIN = false;
    const float* srcA; const float* srcB;
    bf16_t* xb; float* ss; const PG8_LAS float* tab;
    __device__ __forceinline__ void kscale(f32x4 (&acc)[2][2][4][2], int ui, int which, int wr, int fr) const {
#pragma unroll
        for (int ai = 0; ai < 2; ++ai)
#pragma unroll
            for (int m = 0; m < 4; ++m) { const float f = tab[(ui * 256 + ai * HALF + wr * 64 + m * 16 + fr) * 4 + which];
#pragma unroll
                for (int bj = 0; bj < 2; ++bj)
#pragma unroll
                    for (int n = 0; n < 2; ++n) acc[ai][bj][m][n] = acc[ai][bj][m][n] * f; }
    }
    __device__ __forceinline__ void final(const f32x4 (&acc)[2][2][4][2], const Unit& u, int ui, int wr, int wc, int fr, int fq) const {
        const int row0 = u.pm * BM + wr * 64 + fr, col0 = u.pn * BM + wc * 32 + 8 * fq;
#pragma unroll
        for (int ai = 0; ai < 2; ++ai)
#pragma unroll
            for (int m = 0; m < 4; ++m) { const int row = row0 + ai * HALF + m * 16; const float f = tab[(ui * 256 + ai * HALF + wr * 64 + m * 16 + fr) * 4 + 2];
                const float* src = (row < 16384 ? srcA + (size_t)row * 2048 : srcB + (size_t)(row - 16384) * 2048) + col0; float s = 0.f;
#pragma unroll
                for (int bj = 0; bj < 2; ++bj) { const f32x4 v0 = acc[ai][bj][m][0] * f + __builtin_nontemporal_load((const f32x4*)(src + bj * HALF)), v1 = acc[ai][bj][m][1] * f + __builtin_nontemporal_load((const f32x4*)(src + bj * HALF + 4));
                    s += (v0[0] * v0[0] + v0[1] * v0[1]) + (v0[2] * v0[2] + v0[3] * v0[3]) + (v1[0] * v1[0] + v1[1] * v1[1]) + (v1[2] * v1[2] + v1[3] * v1[3]);
                    u32x4 w; w.x = cvt_pk_bf16(v0[0], v0[1]); w.y = cvt_pk_bf16(v0[2], v0[3]); w.z = cvt_pk_bf16(v1[0], v1[1]); w.w = cvt_pk_bf16(v1[2], v1[3]);
                    *(u32x4*)(xb + (size_t)row * 2048 + col0 + bj * HALF) = w; }
                s = sum_x32(sum_x16(s)); asm volatile("" : "+v"(s));
                if (fq == 0) atomicAdd(ss + row, s); }
    }
    __device__ __forceinline__ void operator()(const f32x4 (&acc)[2][2][4][2], const Unit& u, int wr, int wc, int fr, int fq) const {}
};
struct EpiResidB {
    static constexpr bool PERM = true, AFTER_DRAIN = false;
    bf16_t* xb; float* ss; int row_base;
    __device__ __forceinline__ void operator()(const f32x4 (&acc)[2][2][4][2], const Unit& u, int wr, int wc, int fr, int fq) const {
        const int row0 = row_base + u.pm * BM + wr * 64 + fr, col0 = u.pn * BM + wc * 32 + 8 * fq;
#pragma unroll
        for (int ai = 0; ai < 2; ++ai)
#pragma unroll
            for (int m = 0; m < 4; ++m) { const int row = row0 + ai * HALF + m * 16; bf16_t* rp = xb + (size_t)row * 2048 + col0; float s = 0.f;
#pragma unroll
                for (int bj = 0; bj < 2; ++bj) { const u32x4 x = *(const u32x4*)(rp + bj * HALF); float v[8];
#pragma unroll
                    for (int e = 0; e < 4; ++e) { v[2 * e] = __builtin_bit_cast(float, x[e] << 16) + acc[ai][bj][m][e >> 1][(2 * e) & 3]; v[2 * e + 1] = __builtin_bit_cast(float, x[e] & 0xffff0000u) + acc[ai][bj][m][e >> 1][(2 * e + 1) & 3]; }
#pragma unroll
                    for (int e = 0; e < 8; ++e) s += v[e] * v[e];
                    u32x4 w; w.x = cvt_pk_bf16(v[0], v[1]); w.y = cvt_pk_bf16(v[2], v[3]); w.z = cvt_pk_bf16(v[4], v[5]); w.w = cvt_pk_bf16(v[6], v[7]);
                    *(u32x4*)(rp + bj * HALF) = w; }
                s = sum_x32(sum_x16(s)); asm volatile("" : "+v"(s));
                if (fq == 0) atomicAdd(ss + row, s); }
    }
};
struct EpiSwiglu {
    static constexpr bool PERM = true, AFTER_DRAIN = false;
    bf16_t* act; const float* ss; int row_base;
    __device__ __forceinline__ void operator()(const f32x4 (&acc)[2][2][4][2], const Unit& u, int wr, int wc, int fr, int fq) const {
        const int row0 = u.pm * BM + wr * 64 + fr, col0 = u.pn * HALF + wc * 32 + 8 * fq;
#pragma unroll
        for (int ai = 0; ai < 2; ++ai)
#pragma unroll
            for (int m = 0; m < 4; ++m) { const int row = row0 + ai * HALF + m * 16; const float rs = __builtin_amdgcn_rsqf(ss[row_base + row] * (1.0f / 2048.0f) + 1e-6f);
                float a[8];
#pragma unroll
                for (int n = 0; n < 2; ++n)
#pragma unroll
                    for (int j = 0; j < 4; ++j) { const float g = acc[ai][0][m][n][j] * rs, uu = acc[ai][1][m][n][j] * rs;
                        a[n * 4 + j] = g * uu * __builtin_amdgcn_rcpf(1.0f + __builtin_amdgcn_exp2f(-1.4426950408889634f * g)); }
                u32x4 w; w.x = cvt_pk_bf16(a[0], a[1]); w.y = cvt_pk_bf16(a[2], a[3]); w.z = cvt_pk_bf16(a[4], a[5]); w.w = cvt_pk_bf16(a[6], a[7]);
                *(u32x4*)(act + (size_t)row * 5632 + col0) = w; }
    }
};
}

struct TItem { const float* W; const float* gain; bf16_t* WT; int K, N, k0, n0, drow0; };
__device__ __forceinline__ void titem_load(const TItem& t, float (&r)[32], int lane) {
    const float* p = t.W + (size_t)(t.k0 + (lane >> 5)) * t.N + t.n0 + (lane & 31);
#pragma unroll
    for (int i = 0; i < 32; ++i) r[i] = __builtin_nontemporal_load(p + (size_t)(2 * i) * t.N);
}
__device__ __forceinline__ void titem_store(const TItem& t, const float (&r)[32], LAS float* scr, int lane) {
#pragma unroll
    for (int i = 0; i < 32; ++i) scr[(2 * i + (lane >> 5)) * 33 + (lane & 31)] = r[i];
    LDS_WAIT(); asm volatile("" ::: "memory");
    const int c = lane & 7;
    f32x4 g0 = {1.f, 1.f, 1.f, 1.f}, g1 = g0;
    if (t.gain) { g0 = *(const f32x4*)(t.gain + t.k0 + 8 * c); g1 = *(const f32x4*)(t.gain + t.k0 + 8 * c + 4); }
#pragma unroll
    for (int j = 0; j < 4; ++j) { const int n = (lane >> 3) + 8 * j; const LAS float* s = scr + (8 * c) * 33 + n;
        v4u o; o.x = pk2(s[0 * 33] * g0.x, s[1 * 33] * g0.y); o.y = pk2(s[2 * 33] * g0.z, s[3 * 33] * g0.w); o.z = pk2(s[4 * 33] * g1.x, s[5 * 33] * g1.y); o.w = pk2(s[6 * 33] * g1.z, s[7 * 33] * g1.w);
        *(v4u*)(t.WT + (size_t)(t.drow0 + n) * t.K + t.k0 + 8 * c) = o; }
    LDS_WAIT(); asm volatile("" ::: "memory");
}
__device__ __forceinline__ void rows4_to_bf16(const float* __restrict__ x0, bf16_t* __restrict__ o0, float* __restrict__ rstd_out, int lane) {
    f32x4 v[4][8];
#pragma unroll
    for (int r = 0; r < 4; ++r)
#pragma unroll
        for (int j = 0; j < 8; ++j) v[r][j] = __builtin_nontemporal_load((const f32x4*)(x0 + (size_t)r * 2048) + lane + 64 * j);
#pragma unroll
    for (int r = 0; r < 4; ++r) { float s = 0.f;
#pragma unroll
        for (int j = 0; j < 8; ++j) s += (v[r][j].x * v[r][j].x + v[r][j].y * v[r][j].y) + (v[r][j].z * v[r][j].z + v[r][j].w * v[r][j].w);
        s = wave_sum(s);
        if (lane == 0) rstd_out[r] = 1.0f / sqrtf(s * (1.0f / 2048.0f) + EPS);
        v2u* o8 = (v2u*)(o0 + (size_t)r * 2048) + lane;
#pragma unroll
        for (int j = 0; j < 8; ++j) { v2u w; w.x = pk2(v[r][j].x, v[r][j].y); w.y = pk2(v[r][j].z, v[r][j].w); o8[64 * j] = w; } }
}
__device__ __forceinline__ void sincos_ang(float ang, float& s, float& c) {
    double t = (double)ang * 0.15915494309189535; t -= __builtin_floor(t); const float f = (float)t;
    s = __builtin_amdgcn_sinf(f); c = __builtin_amdgcn_cosf(f);
}

#ifndef ATT_MASK
#define ATT_MASK 7
#endif
struct Params { const float* in[17]; float* out; unsigned char* ws; int ph_lo, ph_hi; };

__global__ void __launch_bounds__(NWAVES * 64, 2) hymba_fwd(Params P) {
    __builtin_assume(__builtin_amdgcn_workitem_id_y() == 0); __builtin_assume(__builtin_amdgcn_workitem_id_z() == 0);
    extern __shared__ __attribute__((aligned(16))) unsigned char lds[];
    cg::grid_group grid = cg::this_grid();
    const int tid = threadIdx.x, lane = tid & 63, wave = __builtin_amdgcn_readfirstlane(tid >> 6);
    const int G = gridDim.x, cu = blockIdx.x;
    const int gw = cu * NWAVES + wave, NGW = G * NWAVES;
    unsigned char* ws = P.ws;
    float* rstd1 = (float*)(ws + WS_RSTD1); float* ss2 = (float*)(ws + WS_SS2); float* ss3 = (float*)(ws + WS_SS3); float* rstdm = (float*)(ws + WS_RSTDM);
    bf16_t* WinT = (bf16_t*)(ws + WS_WIN); bf16_t* WmemT = (bf16_t*)(ws + WS_WMEM); bf16_t* WoutT = (bf16_t*)(ws + WS_WOUT); bf16_t* WguT = (bf16_t*)(ws + WS_WGU); bf16_t* WdT = (bf16_t*)(ws + WS_WD);
    bf16_t* kvm = (bf16_t*)(ws + WS_KVM); bf16_t* memb = (bf16_t*)(ws + WS_MEMB);
    bf16_t* xb = (bf16_t*)(ws + WS_XB); bf16_t* Obuf = xb; bf16_t* act = xb;
    float* hs = (float*)(ws + WS_HS);
    bf16_t* proj = (bf16_t*)(ws + WS_PROJ); bf16_t* x1b = (bf16_t*)(ws + WS_X1B);
    const float* x_prompt = P.in[0]; const float* x_sample = P.in[1];
    const int lo = P.ph_lo, hi_ = P.ph_hi;
#ifndef PH_MASK
#define PH_MASK 0x7ff
#endif
#define IN(k) (((PH_MASK >> (k)) & 1) && lo <= (k) && (k) < hi_)
#define SEAM(k) do { if (IN(k) && IN((k) + 1)) grid.sync(); } while (0)

#ifdef PROBE_SYNCS
    for (int i_ = 0; i_ < PROBE_SYNCS; ++i_) grid.sync();
#endif
    if (IN(0)) {
        for (int i = cu * 512 + tid; i < MTOK; i += G * 512) { ss2[i] = 0.f; ss3[i] = 0.f; }
        LAS float* scr = (LAS float*)((LAS unsigned char*)lds + wave * 16384);
        constexpr int I_IN = 32 * 96, I_MEM = 32 * 32, I_OUT = 32 * 64, I_GU = 32 * 352, I_D = 88 * 64;
        constexpr int NITEMS = I_IN + I_MEM + I_OUT + I_GU + I_D;
        auto decode = [&](int it) -> TItem {
            int r = it; TItem t;
            if (r < I_IN) { const int kb = r / 96, nb = r % 96; t = TItem{P.in[6], P.in[4], WinT, 2048, INW, 64 * kb, 32 * nb, 32 * nb}; return t; } r -= I_IN;
            if (r < I_MEM) { const int kb = r / 32, nb = r % 32; t = TItem{P.in[7], P.in[5], WmemT, 2048, MKV, 64 * kb, 32 * nb, 32 * nb}; return t; } r -= I_MEM;
            if (r < I_OUT) { const int kb = r / 64, nb = r % 64; t = TItem{P.in[12], P.in[11], WoutT, 2048, DM, 64 * kb, 32 * nb, 32 * nb}; return t; } r -= I_OUT;
            if (r < I_GU) { const int kb = r / 352, nb = r % 352; const int n0 = 32 * nb; const int nn = n0 < DFF ? n0 : n0 - DFF;
                const int drow = (nn >> 7) * 256 + (n0 < DFF ? 0 : 128) + (nn & 127);
                t = TItem{P.in[14], P.in[13], WguT, 2048, NGU, 64 * kb, n0, drow}; return t; } r -= I_GU;
            { const int kb = r / 64, nb = r % 64; t = TItem{P.in[15], nullptr, WdT, DFF, DM, 64 * kb, 32 * nb, 32 * nb}; return t; }
        };
        {
            float ra[32], rb[32]; int it = gw;
            TItem ta, tb;
            if (it < NITEMS) { ta = decode(it); titem_load(ta, ra, lane); }
            while (it < NITEMS) {
                const int itb = it + NGW; if (itb < NITEMS) { tb = decode(itb); titem_load(tb, rb, lane); }
                titem_store(ta, ra, scr, lane);
                if (itb >= NITEMS) break;
                const int ita = itb + NGW; if (ita < NITEMS) { ta = decode(ita); titem_load(ta, ra, lane); }
                titem_store(tb, rb, scr, lane);
                it = ita;
            }
        }
        for (int m = gw * 4; m < MTOK; m += NGW * 4) rows4_to_bf16(m < SEQ0 ? x_prompt + (size_t)m * DM : x_sample + (size_t)(m - SEQ0) * DM, xb + (size_t)m * DM, rstd1 + m, lane);
        for (int m = gw * 4; m < MEMR; m += NGW * 4) rows4_to_bf16(m < 256 ? P.in[2] + (size_t)m * DM : P.in[3] + (size_t)(m - 256) * DM, memb + (size_t)m * DM, rstdm + m, lane);
    }
    SEAM(0);

    if (IN(1)) {
        { pg8::Gemm g{xb, WinT, MTOK, INW, DM}; pg8::StaticOrder S; S.init(MTOK, INW, G, cu);
          pg8::EpiScaleBf16 E{proj, INW, rstd1};
          pg8::gemm_phase<pg8::EpiScaleBf16, pg8::StaticOrder, true, true>((LAS unsigned char*)lds, g, S, E); }
    }
    SEAM(1);

    if (IN(2)) {
        int tidf_ = threadIdx.x; asm volatile("" : "+v"(tidf_)); const int lane = tidf_ & 63, wave = __builtin_amdgcn_readfirstlane(tidf_ >> 6), gw = cu * NWAVES + wave; (void)lane; (void)gw;
        for (int task = wave * G + cu; task < 768; task += NWAVES * G) {
            const int mt = task >> 4, nt = task & 15, fr = lane & 15, fq = lane >> 4;
            const bf16_t* ap = memb + (size_t)(mt * 16 + fr) * DM + fq * 8;
            const bf16_t* bp = WmemT + (size_t)(nt * 64 + fr) * DM + fq * 8;
            f32x4 acc[4] = {};
#pragma unroll 4
            for (int k0 = 0; k0 < DM; k0 += 32) {
                const pg8::bf16x8 a = *(const pg8::bf16x8*)(ap + k0);
#pragma unroll
                for (int j = 0; j < 4; ++j) { const pg8::bf16x8 b = *(const pg8::bf16x8*)(bp + (size_t)j * 16 * DM + k0);
                    acc[j] = __builtin_amdgcn_mfma_f32_16x16x32_bf16(a, b, acc[j], 0, 0, 0); }
            }
#pragma unroll
            for (int i = 0; i < 4; ++i) { const int row = mt * 16 + fq * 4 + i; const float rs = rstdm[row];
#pragma unroll
                for (int j = 0; j < 4; ++j) kvm[(size_t)row * MKV + nt * 64 + j * 16 + fr] = (bf16_t)f2bf(acc[j][i] * rs); }
        }
        const float L2T = 13.287712379549449f;
        const int l5 = lane & 31, l4 = lane & 15;
        const float invA0 = exp2f(-(float)(2 * l5) * (L2T / 64.0f)), invA1 = exp2f(-(float)(2 * l5 + 1) * (L2T / 64.0f));
        const float invB0 = exp2f(-(float)(2 * l4) * (L2T / 32.0f)), invB1 = exp2f(-(float)(2 * l4 + 1) * (L2T / 32.0f));
        const float sgnA = (lane & 32) ? 1.f : -1.f, sgnB = (lane & 16) ? 1.f : -1.f;
        const float kg0 = P.in[10][2 * lane], kg1 = P.in[10][2 * lane + 1];
        for (int row0 = gw * 4; row0 < MTOK; row0 += NGW * 4) {
            unsigned wq[4][4];
#pragma unroll
            for (int r = 0; r < 4; ++r) { const unsigned* prow = (const unsigned*)(proj + (size_t)(row0 + r) * INW);
#pragma unroll
                for (int h = 0; h < 2; ++h) { wq[r][h] = prow[512 + h * 64 + lane]; wq[r][2 + h] = prow[1024 + h * 64 + lane]; } }
#pragma unroll
            for (int r = 0; r < 4; ++r) { const int row = row0 + r;
                const int t = row < SEQ0 ? row : ((row - SEQ0) & (SEQS - 1));
                unsigned* prow = (unsigned*)(proj + (size_t)row * INW);
                float sa0, ca0, sa1, ca1; sincos_ang((float)t * invA0, sa0, ca0); sincos_ang((float)t * invA1, sa1, ca1);
                sa0 *= sgnA; sa1 *= sgnA;
#pragma unroll
                for (int h = 0; h < 2; ++h) { const unsigned w = wq[r][h]; const unsigned pw = (unsigned)__shfl_xor((int)w, 32);
                    const float y0 = bflo(w) * ca0 + bflo(pw) * sa0, y1 = bfhi(w) * ca1 + bfhi(pw) * sa1;
                    prow[512 + h * 64 + lane] = pk2(y0, y1); }
                const float posB = (float)((lane & 32) ? (t & 63) : (t >> 6));
                float sb0, cb0, sb1, cb1; sincos_ang(posB * invB0, sb0, cb0); sincos_ang(posB * invB1, sb1, cb1);
                sb0 *= sgnB; sb1 *= sgnB;
#pragma unroll
                for (int h = 0; h < 2; ++h) { const unsigned w = wq[r][2 + h]; float x0 = bflo(w), x1 = bfhi(w);
                    const float ssq = wave_sum(x0 * x0 + x1 * x1); const float rr = 1.0f / sqrtf(ssq * (1.0f / 128.0f) + EPS);
                    x0 *= rr * kg0; x1 *= rr * kg1;
                    const float p0 = __shfl_xor(x0, 16), p1 = __shfl_xor(x1, 16);
                    prow[1024 + h * 64 + lane] = pk2(x0 * cb0 + p0 * sb0, x1 * cb1 + p1 * sb1); }
            }
        }
    }
    SEAM(2);

    if (IN(3)) {
        const att::bf16* pj = (const att::bf16*)proj; const att::bf16* kv = (const att::bf16*)kvm;
        if (ATT_MASK & 1) for (int ub = cu; ub < 512; ub += G) {
            const int v = ub & 255, xcd = v & 7, idx = v >> 3; int head, row0, srow, slen;
            if (ub < 256) { head = xcd >> 1; row0 = ((xcd & 1) * 32 + idx) * 256; srow = 0; slen = SEQ0; }
            else { const int b = xcd >> 2; head = xcd & 3; srow = SEQ0 + b * SEQS; slen = SEQS; row0 = srow + idx * 256; }
            const int kvh = head >> 1;
            att::attn_body<0, 2>(pj + (size_t)row0 * INW + 1536 + head * 128, pj + (size_t)srow * INW + 2048 + kvh * 128, pj + (size_t)srow * INW + 2304 + kvh * 128,
                                 Obuf + (size_t)row0 * DM + 1024 + head * 128, hs + (size_t)row0 * 16 + 8 + head, slen, INW, 0, nullptr, row0 - srow, P.in[9], (char*)lds);
        }
        if (ATT_MASK & 2) for (int ua = cu; ua < 1024; ua += G) {
            const int hp = ua & 3, row0 = (ua >> 2) * 128, h0 = hp * 2, kvh = hp >> 1;
            const int srow = row0 < SEQ0 ? 0 : SEQ0 + ((row0 - SEQ0) / SEQS) * SEQS, send = row0 < SEQ0 ? SEQ0 : srow + SEQS;
            const int ks = max(row0 - 128, srow), ke = min(row0 + 256, send);
            att::attn_body<1, 1>(pj + (size_t)row0 * INW + h0 * 128, pj + (size_t)ks * INW + 1024 + kvh * 128, pj + (size_t)ks * INW + 1280 + kvh * 128,
                                 Obuf + (size_t)row0 * DM + h0 * 128, hs + (size_t)row0 * 16 + h0, ke - ks, INW, row0 - ks, P.in[8] + h0, row0 - srow, nullptr, (char*)lds);
        }
        if (ATT_MASK & 4) for (int um = cu; um < 512; um += G) {
            const int head = um & 3, qb = um >> 2, row0 = qb * 256; const int sq = row0 < SEQ0 ? 0 : 1 + (row0 - SEQ0) / SEQS;
            att::attn_body<0, 0>(pj + (size_t)row0 * INW + 2560 + head * 128, kv + (size_t)sq * 256 * MKV + head * 128, kv + (size_t)sq * 256 * MKV + 512 + head * 128,
                                 Obuf + (size_t)row0 * DM + 1536 + head * 128, hs + (size_t)row0 * 16 + 12 + head, 256, MKV, 0, nullptr, 0, nullptr, (char*)lds);
        }
    }
    SEAM(3);

    SEAM(4);

    if (IN(5)) {
        pg8::Gemm g{Obuf, WoutT, MTOK, DM, DM}; pg8::StaticOrder S; S.init(MTOK, DM, G, cu);
        LAS float* tab = (LAS float*)((LAS unsigned char*)lds + 131072);
        {
            pg8::Unit u;
            for (int ui = 0; ui < 4 && S.next(ui, u); ++ui) if (tid < 256) {
                const f32x4* hp = (const f32x4*)(hs + (size_t)(u.pm * 256 + tid) * 16);
                const f32x4 a0 = hp[0], a1 = hp[1], b0 = hp[2], m0 = hp[3];
                const float sA = ((a0[0] + a0[1]) + (a0[2] + a0[3])) + ((a1[0] + a1[1]) + (a1[2] + a1[3])), sB = (b0[0] + b0[1]) + (b0[2] + b0[3]), sM = (m0[0] + m0[1]) + (m0[2] + m0[3]);
                const float rA = 1.0f / sqrtf(sA * (1.0f / 1024.0f) + EPS), rB = 1.0f / sqrtf(sB * (1.0f / 512.0f) + EPS), rM = 1.0f / sqrtf(sM * (1.0f / 512.0f) + EPS);
                f32x4 t4; t4[0] = rA / rB; t4[1] = rB / rM; t4[2] = rM; t4[3] = 0.f;
                *(LAS f32x4*)(tab + (ui * 256 + tid) * 4) = t4;
            }
            __syncthreads();
        }
        pg8::EpiResidX E{x_prompt, x_sample, x1b, ss2, (const LAS float*)tab};
        pg8::gemm_phase<pg8::EpiResidX, pg8::StaticOrder, true, true, true>((LAS unsigned char*)lds, g, S, E);
    }
    SEAM(5);

#pragma unroll
    for (int half = 0; half < 2; ++half) {
        const int rb = half * 16384;
        if (IN(6 + 2 * half)) {
            pg8::Gemm g{x1b + (size_t)rb * DM, WguT, 16384, NGU, DM}; pg8::StaticOrder S; S.init(16384, NGU, G, cu);
            pg8::EpiSwiglu E{act, ss2, rb};
            pg8::gemm_phase<pg8::EpiSwiglu, pg8::StaticOrder, true, true>((LAS unsigned char*)lds, g, S, E);
        }
        SEAM(6 + 2 * half);
        if (IN(7 + 2 * half)) {
            pg8::Gemm g{act, WdT, 16384, DM, DFF}; pg8::StaticOrder S; S.init(16384, DM, G, cu);
            pg8::EpiResidB E{x1b, ss3, rb};
            pg8::gemm_phase<pg8::EpiResidB, pg8::StaticOrder, true, true>((LAS unsigned char*)lds, g, S, E);
        }
        SEAM(7 + 2 * half);
    }

    if (IN(10)) {
        int tidf_ = threadIdx.x; asm volatile("" : "+v"(tidf_)); const int lane = tidf_ & 63, wave = __builtin_amdgcn_readfirstlane(tidf_ >> 6), gw = cu * NWAVES + wave; (void)lane; (void)gw;
        const f32x4* gf = (const f32x4*)P.in[16] + lane; f32x4 gv[8];
#pragma unroll
        for (int j = 0; j < 8; ++j) gv[j] = gf[64 * j];
        for (int row0 = gw * 4; row0 < MTOK; row0 += NGW * 4) {
            v2u y[4][8]; float rs[4];
#pragma unroll
            for (int r = 0; r < 4; ++r) { rs[r] = ss3[row0 + r];
#pragma unroll
                for (int j = 0; j < 8; ++j) y[r][j] = __builtin_nontemporal_load((const v2u*)(x1b + (size_t)(row0 + r) * DM) + lane + 64 * j); }
#pragma unroll
            for (int r = 0; r < 4; ++r) { const float q = 1.0f / sqrtf(rs[r] * (1.0f / 2048.0f) + EPS);
                f32x4* op = (f32x4*)(P.out + (size_t)(row0 + r) * DM) + lane;
#pragma unroll
                for (int j = 0; j < 8; ++j) { f32x4 v; v.x = bflo(y[r][j].x); v.y = bfhi(y[r][j].x); v.z = bflo(y[r][j].y); v.w = bfhi(y[r][j].y); __builtin_nontemporal_store(v * q * gv[j], op + 64 * j); } }
        }
    }
#undef IN
#undef SEAM
}

constexpr int NPH = 11;
#ifndef N_SPLIT
#define N_SPLIT 0
#endif
extern "C" void kernel_launch(void* const* d_in, const int* in_sizes, int n_in, void* d_out, int out_size, void* d_ws, size_t ws_size, hipStream_t stream) {
    static int grid = 0;
    if (grid == 0) {
        if (n_in != 17 || out_size != MTOK * DM || ws_size < WS_END) { fprintf(stderr, "kernel_launch: unexpected shapes n_in %d out %d ws %zu\n", n_in, out_size, ws_size); grid = -1; return; }
        int dev = 0, cus = 0, per_cu = 0;
        (void)hipGetDevice(&dev); (void)hipDeviceGetAttribute(&cus, hipDeviceAttributeMultiprocessorCount, dev);
        if (hipFuncSetAttribute((const void*)hymba_fwd, hipFuncAttributeMaxDynamicSharedMemorySize, LDS_BYTES) != hipSuccess) { fprintf(stderr, "kernel_launch: hipFuncSetAttribute failed\n"); grid = -1; return; }
        (void)hipOccupancyMaxActiveBlocksPerMultiprocessor(&per_cu, (const void*)hymba_fwd, NWAVES * 64, LDS_BYTES);
        if (per_cu < 1) { fprintf(stderr, "kernel_launch: occupancy query says %d blocks per CU\n", per_cu); per_cu = 1; }
        (void)hipGetLastError();
        grid = cus;
    }
    if (grid < 0) return;
    Params p{};
    for (int i = 0; i < 17; ++i) p.in[i] = (const float*)d_in[i];
    p.out = (float*)d_out; p.ws = (unsigned char*)d_ws;
#if N_SPLIT
    for (int k = 0; k < NPH; ++k) { p.ph_lo = k; p.ph_hi = k + 1; hipLaunchKernelGGL(hymba_fwd, dim3(grid), dim3(NWAVES * 64), LDS_BYTES, stream, p); }
#else
    void* args[] = {&p};
#ifdef PROBE_REPEAT
    p.ph_lo = 0; p.ph_hi = PROBE_REPEAT + 1;
    (void)hipLaunchCooperativeKernel((const void*)hymba_fwd, dim3(grid), dim3(NWAVES * 64), args, LDS_BYTES, stream);
    p.ph_lo = PROBE_REPEAT; p.ph_hi = NPH;
    (void)hipLaunchCooperativeKernel((const void*)hymba_fwd, dim3(grid), dim3(NWAVES * 64), args, LDS_BYTES, stream);
#else
    p.ph_lo = 0; p.ph_hi = NPH;
    hipError_t e = hipLaunchCooperativeKernel((const void*)hymba_fwd, dim3(grid), dim3(NWAVES * 64), args, LDS_BYTES, stream);
    if (e != hipSuccess) fprintf(stderr, "cooperative launch failed: %s (grid %d)\n", hipGetErrorString(e), grid);
#endif
#endif
}
```
